# Optimizing an MI355X kernel written in HIP

```python
import numpy as np
import jax, jax.numpy as jnp
from jax import lax

D_MODEL = 1024
BATCH = 2
SEQ = 16384
DEPTH = 4

CHUNK = 64
N_MIXERS = 4
HEAD_DIM = 64
MIX_WIDTH = D_MODEL
MEM_LEN = 256
X_HEADS = 4
X_WIDTH = X_HEADS * HEAD_DIM
BRANCH_WIDTH = MIX_WIDTH + X_WIDTH
SG_BLOCK = 128
SG_GROUPS = 8
SG_GROUP_CH = MIX_WIDTH // SG_GROUPS
SWA_WINDOW = 128
SWA_Q_HEADS = MIX_WIDTH // HEAD_DIM
SWA_KV_HEADS = 2
SWA_GROUP = SWA_Q_HEADS // SWA_KV_HEADS
WINDOW_CHUNKS = SWA_WINDOW // CHUNK
BAND = (WINDOW_CHUNKS + 1) * CHUNK
REL_BUCKETS = 32
REL_MAX_DIST = 128
CONV_WIDTH = 31
SHORT_CONV_WIDTH = 3
D_FF = -(-8 * D_MODEL // (3 * 256)) * 256
DEEPNORM_ALPHA = (2 * DEPTH) ** 0.25
DEEPNORM_BETA = (8 * DEPTH) ** -0.25
LN_EPS = 1e-5
NEG_INF = -1e30
N_PER_TYPE = tuple(len(range(m, DEPTH, N_MIXERS)) for m in range(N_MIXERS))

kernel_name = 'hybrid_chunk_causal_interleaved_trunk'


def layer_norm(x, g, b):
    xf = x.astype(jnp.float32)
    mu = jnp.mean(xf, -1, keepdims=True)
    var = jnp.mean(jnp.square(xf - mu), -1, keepdims=True)
    y = (xf - mu) * lax.rsqrt(var + LN_EPS)
    return (y * g.astype(jnp.float32) + b.astype(jnp.float32)).astype(x.dtype)


def causal_depthwise_conv(x, w):
    k = w.shape[0]
    return lax.conv_general_dilated(
        x, w[:, None, :].astype(x.dtype), window_strides=(1,), padding=[(k - 1, 0)],
        dimension_numbers=('NWC', 'WIO', 'NWC'), feature_group_count=x.shape[-1])


def t5_bucket(rel):
    nb = REL_BUCKETS // 2
    ret = (rel > 0).astype(np.int32) * nb
    n = np.abs(rel)
    max_exact = nb // 2
    large = max_exact + (np.log(np.maximum(n, 1) / max_exact)
                         / np.log(REL_MAX_DIST / max_exact) * (nb - max_exact)).astype(np.int32)
    large = np.minimum(large, nb - 1)
    return (ret + np.where(n < max_exact, n, large)).astype(np.int32)


def spatial_gating_mixer(x, w_in, v_g, v_b, w_s, b_s):
    bsz, s, _ = x.shape
    h = x @ w_in
    z = jax.nn.gelu(h[..., :2 * MIX_WIDTH])
    qx = h[..., 2 * MIX_WIDTH:]
    u = z[..., :MIX_WIDTH]
    v = layer_norm(z[..., MIX_WIDTH:], v_g, v_b)
    pos = np.arange(SG_BLOCK) // CHUNK
    mask = pos[None, :] <= pos[:, None]
    w_m = jnp.where(mask[None], w_s, 0.0)
    v = v.reshape(bsz, s // SG_BLOCK, SG_BLOCK, SG_GROUPS, SG_GROUP_CH)
    sv = jnp.einsum('gij,bnjgc->bnigc', w_m, v) + b_s.T[:, :, None]
    return u * sv.reshape(bsz, s, MIX_WIDTH), qx


def swa_sink_mixer(x, w_in, sinks, rel_bias):
    bsz, s, _ = x.shape
    n_chunks = s // CHUNK
    kv_w = SWA_KV_HEADS * HEAD_DIM
    h = x @ w_in
    q = h[..., :MIX_WIDTH].reshape(bsz, n_chunks, CHUNK, SWA_KV_HEADS, SWA_GROUP, HEAD_DIM)
    k = h[..., MIX_WIDTH:MIX_WIDTH + kv_w]
    v = h[..., MIX_WIDTH + kv_w:MIX_WIDTH + 2 * kv_w]
    qx = h[..., MIX_WIDTH + 2 * kv_w:]

    def band(t):
        t = jnp.pad(t, ((0, 0), (WINDOW_CHUNKS * CHUNK, 0), (0, 0)))
        t = t.reshape(bsz, n_chunks + WINDOW_CHUNKS, CHUNK, SWA_KV_HEADS, HEAD_DIM)
        return jnp.concatenate([t[:, w:w + n_chunks] for w in range(WINDOW_CHUNKS + 1)], axis=2)

    kb, vb = band(k), band(v)
    scores = jnp.einsum('bnqkgd,bnskd->bnkgqs', q, kb).astype(jnp.float32) * (HEAD_DIM ** -0.5)
    qpos = np.arange(CHUNK)[:, None]
    kpos = np.arange(BAND)[None, :] - WINDOW_CHUNKS * CHUNK
    buckets = t5_bucket(kpos - qpos)
    bias = rel_bias.astype(jnp.float32)[buckets]
    bias = bias.transpose(2, 0, 1).reshape(SWA_KV_HEADS, SWA_GROUP, CHUNK, BAND)
    valid = (np.arange(n_chunks)[:, None] + np.arange(BAND)[None, :] // CHUNK - WINDOW_CHUNKS) >= 0
    scores = jnp.where(valid[None, :, None, None, None, :], scores + bias, NEG_INF)
    sink = jnp.broadcast_to(sinks.astype(jnp.float32).reshape(SWA_KV_HEADS, SWA_GROUP, 1, 1),
                            scores.shape[:-1] + (1,))
    probs = jax.nn.softmax(jnp.concatenate([scores, sink], axis=-1), axis=-1)[..., :BAND]
    out = jnp.einsum('bnkgqs,bnskd->bnqkgd', probs.astype(x.dtype), vb)
    return out.reshape(bsz, s, MIX_WIDTH), qx


def conformer_conv_mixer(x, w_in, conv_w, conv_b, ln_g, ln_b):
    h = x @ w_in
    a, g = h[..., :MIX_WIDTH], h[..., MIX_WIDTH:2 * MIX_WIDTH]
    qx = h[..., 2 * MIX_WIDTH:]
    y = causal_depthwise_conv(a * jax.nn.sigmoid(g), conv_w) + conv_b
    return jax.nn.silu(layer_norm(y, ln_g, ln_b)), qx


def short_conv_mixer(x, w_in, conv_w):
    h = x @ w_in
    bg = h[..., :MIX_WIDTH]
    cg = h[..., MIX_WIDTH:2 * MIX_WIDTH]
    hv = h[..., 2 * MIX_WIDTH:3 * MIX_WIDTH]
    qx = h[..., 3 * MIX_WIDTH:]
    return bg * causal_depthwise_conv(cg * hv, conv_w), qx


def memory_cross_attention(qx, mem, w_mem_kv):
    bsz, s, _ = qx.shape
    q = qx.reshape(bsz, s, X_HEADS, HEAD_DIM)
    kv = (mem @ w_mem_kv).reshape(bsz, mem.shape[1], 2, X_HEADS, HEAD_DIM)
    sc = jnp.einsum('bshd,bmhd->bhsm', q, kv[:, :, 0]).astype(jnp.float32) * (HEAD_DIM ** -0.5)
    p = jax.nn.softmax(sc, axis=-1).astype(qx.dtype)
    return jnp.einsum('bhsm,bmhd->bshd', p, kv[:, :, 1]).reshape(bsz, s, X_WIDTH)


def swiglu_ffn(x, w_in, w_down):
    h = x @ w_in
    return (jax.nn.silu(h[..., :D_FF]) * h[..., D_FF:]) @ w_down


def setup_inputs(seed: int = 0) -> dict:
    key = jax.random.key(seed)
    ks = iter(jax.random.split(key, 48))

    def nrm(shape, scale):
        return jax.random.normal(next(ks), shape, jnp.float32) * scale

    n_a, n_b, n_c, n_d = N_PER_TYPE
    d = D_MODEL
    return {
        'x': nrm((BATCH, SEQ, d), 1.0),
        'mem': nrm((BATCH, MEM_LEN, d), 1.0),
        'a_w_in': nrm((n_a, d, 2 * MIX_WIDTH + X_WIDTH), d ** -0.5),
        'a_v_ln_g': 1.0 + nrm((n_a, MIX_WIDTH), 0.02),
        'a_v_ln_b': nrm((n_a, MIX_WIDTH), 0.02),
        'a_w_s': nrm((n_a, SG_GROUPS, SG_BLOCK, SG_BLOCK), SG_BLOCK ** -0.5),
        'a_b_s': 1.0 + nrm((n_a, SG_GROUPS, SG_BLOCK), 0.02),
        'b_w_in': nrm((n_b, d, MIX_WIDTH + 2 * SWA_KV_HEADS * HEAD_DIM + X_WIDTH), d ** -0.5),
        'b_sinks': nrm((n_b, SWA_Q_HEADS), 0.5),
        'rel_bias': nrm((REL_BUCKETS, SWA_Q_HEADS), 0.1),
        'c_w_in': nrm((n_c, d, 2 * MIX_WIDTH + X_WIDTH), d ** -0.5),
        'c_conv_w': nrm((n_c, CONV_WIDTH, MIX_WIDTH), CONV_WIDTH ** -0.5),
        'c_conv_b': nrm((n_c, MIX_WIDTH), 0.02),
        'c_ln_g': 1.0 + nrm((n_c, MIX_WIDTH), 0.02),
        'c_ln_b': nrm((n_c, MIX_WIDTH), 0.02),
        'd_w_in': nrm((n_d, d, 3 * MIX_WIDTH + X_WIDTH), d ** -0.5),
        'd_conv_w': nrm((n_d, SHORT_CONV_WIDTH, MIX_WIDTH), SHORT_CONV_WIDTH ** -0.5),
        'w_mem_kv': nrm((DEPTH, d, 2 * X_WIDTH), d ** -0.5),
        'w_o': nrm((DEPTH, BRANCH_WIDTH, d), BRANCH_WIDTH ** -0.5 * DEEPNORM_BETA),
        'ln1_g': 1.0 + nrm((DEPTH, d), 0.02),
        'ln1_b': nrm((DEPTH, d), 0.02),
        'ffn_w_in': nrm((DEPTH, d, 2 * D_FF), d ** -0.5),
        'ffn_w_down': nrm((DEPTH, D_FF, d), D_FF ** -0.5 * DEEPNORM_BETA),
        'ln2_g': 1.0 + nrm((DEPTH, d), 0.02),
        'ln2_b': nrm((DEPTH, d), 0.02),
    }


def reference(x, mem, a_w_in, a_v_ln_g, a_v_ln_b, a_w_s, a_b_s, b_w_in, b_sinks, rel_bias,
              c_w_in, c_conv_w, c_conv_b, c_ln_g, c_ln_b, d_w_in, d_conv_w, w_mem_kv, w_o,
              ln1_g, ln1_b, ffn_w_in, ffn_w_down, ln2_g, ln2_b):
    for i in range(DEPTH):
        m, j = i % N_MIXERS, i // N_MIXERS
        if m == 0:
            mix, qx = spatial_gating_mixer(x, a_w_in[j], a_v_ln_g[j], a_v_ln_b[j], a_w_s[j], a_b_s[j])
        elif m == 1:
            mix, qx = swa_sink_mixer(x, b_w_in[j], b_sinks[j], rel_bias)
        elif m == 2:
            mix, qx = conformer_conv_mixer(x, c_w_in[j], c_conv_w[j], c_conv_b[j], c_ln_g[j], c_ln_b[j])
        else:
            mix, qx = short_conv_mixer(x, d_w_in[j], d_conv_w[j])
        branch = jnp.concatenate([mix, memory_cross_attention(qx, mem, w_mem_kv[i])], axis=-1)
        x = layer_norm(DEEPNORM_ALPHA * x + branch @ w_o[i], ln1_g[i], ln1_b[i])
        x = layer_norm(DEEPNORM_ALPHA * x + swiglu_ffn(x, ffn_w_in[i], ffn_w_down[i]), ln2_g[i], ln2_b[i])
    return x
```

```cpp
#include <hip/hip_runtime.h>
#include <hip/hip_cooperative_groups.h>
#include <cstdio>
#include <cstdint>
namespace cg = cooperative_groups;
namespace pg8 {
#define PG8_LAS __attribute__((address_space(3)))
typedef unsigned short bf16_t;
typedef short bf16x8 __attribute__((ext_vector_type(8)));
typedef float f32x4 __attribute__((ext_vector_type(4)));
typedef unsigned u32x4 __attribute__((ext_vector_type(4)));
constexpr int BM = 256, BK = 64, HALF = 128, HTB = HALF * BK * 2  , STAGE_BYTES = 8 * HTB, NXCD = 8, WGM = 8;

__host__ __device__ __forceinline__ int lds_byte(int r, int c) { const int st = (r >> 4) * 2 + (c >> 5), rr = r & 15, cc = c & 31, ob = rr * 64 + cc * 2; return st * 1024 + (ob ^ (((ob >> 9) & 1) << 5)); }
__host__ __device__ __forceinline__ void stage_rc(int b, int& R, int& C) { const int st = b / 1024, sb = b % 1024, swz = sb ^ (((sb >> 9) & 1) << 5); R = (st >> 1) * 16 + swz / 64; C = (st & 1) * 32 + (swz % 64) / 2; }
__host__ __device__ __forceinline__ int perm32(int rho) { const int n = rho >> 4, i = rho & 15; return 8 * (i >> 2) + 4 * n + (i & 3); }

struct Unit { int pm, pn; };
struct Gemm { const bf16_t* A; const bf16_t* Bt; int M, N, K; };

struct StaticOrder {
    int nM, nN, nwg, G, c;
    __host__ __device__ void init(int M, int N, int G_, int c_) { nM = M / BM; nN = N / BM; nwg = nM * nN; G = G_; c = c_; }
    __host__ __device__ bool next(int i, Unit& u) const {
        const long L = (long)i * G + c; if (L >= nwg) return false;
        int wgid = (int)L; { const int q = nwg / NXCD, r = nwg % NXCD, xcd = wgid % NXCD, off = wgid / NXCD; wgid = (xcd < r ? xcd * (q + 1) : r * (q + 1) + (xcd - r) * q) + off; }
        const int nig = WGM * nN, gid = wgid / nig, fm = gid * WGM, gsz = (nM - fm) < WGM ? (nM - fm) : WGM;
        u.pm = fm + ((wgid % nig) % gsz); u.pn = (wgid % nig) / gsz; return true;
    }
    __device__ __forceinline__ void a_ready(const Unit&) const {}
    __device__ __forceinline__ void done(const Unit&) const {}
};

__device__ __forceinline__ unsigned cvt_pk_bf16(float lo, float hi) { unsigned r; asm volatile("v_cvt_pk_bf16_f32 %0, %1, %2" : "=v"(r) : "v"(lo), "v"(hi)); return r; }
template <class Epi, class Sched, bool ALIGN_EPI = false, bool SP2 = false>
__device__ __forceinline__ void gemm_phase(PG8_LAS unsigned char* lds, const Gemm g, const Sched& S, const Epi& E) {
    int tid_l = threadIdx.x; asm volatile("" : "+v"(tid_l));
    const int tid = tid_l, wid = __builtin_amdgcn_readfirstlane(tid >> 6), lane = tid & 63, wr = wid >> 2, wc = wid & 3, fr = lane & 15, fq = lane >> 4;
    const int K = g.K, nt = K / BK;
    unsigned voffA[2], voffB[2];
#pragma unroll
    for (int i = 0; i < 2; ++i) { int R, C; stage_rc(tid * 16 + i * 8192, R, C); const int Rb = Epi::PERM ? ((R & ~31) + perm32(R & 31)) : R;
        voffA[i] = (unsigned)(R * K + C) * 2u; voffB[i] = (unsigned)(Rb * K + C) * 2u; }
    const size_t kstep = (size_t)(BK * 2);
    const size_t hstep = (size_t)HALF * K * 2;
    const size_t tstep = 2 * hstep;
    const unsigned ldsw = (unsigned)wid * 1024u;
    const int aoff = lds_byte(wr * 64 + fr, fq * 8), boff = lds_byte(wc * 32 + fr, fq * 8);
#define PG8_SA(b, h) (((b) * 2 + (h)) * HTB)
#define PG8_SB(b, h) ((4 + (b) * 2 + (h)) * HTB)
#define PG8_STAGE(bufoff, gbase, voff) do { _Pragma("unroll") for (int _i = 0; _i < 2; ++_i) \
        __builtin_amdgcn_global_load_lds((const unsigned*)((const char*)(gbase) + (voff)[_i]), (PG8_LAS unsigned*)(lds + (bufoff) + ldsw + _i * 8192), 16, 0, 0); } while (0)
#define PG8_LDA(dst, b, h) do { _Pragma("unroll") for (int m = 0; m < 4; ++m) _Pragma("unroll") for (int k = 0; k < 2; ++k) dst[m][k] = *(const PG8_LAS bf16x8*)(lds + PG8_SA(b, h) + aoff + m * 2048 + k * 1024); } while (0)
#define PG8_LDB(dst, b, h) do { _Pragma("unroll") for (int n = 0; n < 2; ++n) _Pragma("unroll") for (int k = 0; k < 2; ++k) dst[n][k] = *(const PG8_LAS bf16x8*)(lds + PG8_SB(b, h) + boff + n * 2048 + k * 1024); } while (0)
#define PG8_MMA(ai, bj, At, Bt) do { __builtin_amdgcn_s_setprio(1); _Pragma("unroll") for (int m = 0; m < 4; ++m) _Pragma("unroll") for (int n = 0; n < 2; ++n) _Pragma("unroll") for (int k = 0; k < 2; ++k) \
        acc[ai][bj][m][n] = __builtin_amdgcn_mfma_f32_16x16x32_bf16(Bt[n][k], At[m][k], acc[ai][bj][m][n], 0, 0, 0); __builtin_amdgcn_s_setprio(0); } while (0)
#define PG8_WAIT_V(n) asm volatile("s_waitcnt vmcnt(" #n ")" ::: "memory")
#define PG8_WAIT_L(n) asm volatile("s_waitcnt lgkmcnt(" #n ")" ::: "memory")
#define PG8_BAR __builtin_amdgcn_s_barrier()
#define PG8_SCHED __builtin_amdgcn_sched_barrier(0)
    Unit cur, nxt; int ui = 0;
    if (!S.next(0, cur)) return;
    f32x4 acc[2][2][4][2];
#pragma unroll
    for (int a = 0; a < 2; ++a)
#pragma unroll
        for (int b = 0; b < 2; ++b)
#pragma unroll
            for (int m = 0; m < 4; ++m)
#pragma unroll
                for (int n = 0; n < 2; ++n) acc[a][b][m][n] = (f32x4){0.f, 0.f, 0.f, 0.f};
    bf16x8 At[4][2], B0[2][2], B1[2][2];
    const char* cA = (const char*)g.A + (size_t)cur.pm * tstep; const char* cB = (const char*)g.Bt + (size_t)cur.pn * tstep;
    S.a_ready(cur);
    if constexpr (SP2) {
        PG8_STAGE(PG8_SB(0, 0), cB, voffB); PG8_STAGE(PG8_SB(0, 1), cB + hstep, voffB); PG8_STAGE(PG8_SA(0, 0), cA, voffA); PG8_STAGE(PG8_SA(0, 1), cA + hstep, voffA);
        if (wr == 1) PG8_BAR;
        PG8_WAIT_V(2); PG8_BAR;
        PG8_STAGE(PG8_SB(1, 0), cB + kstep, voffB); PG8_STAGE(PG8_SA(1, 0), cA + kstep, voffA); PG8_STAGE(PG8_SB(1, 1), cB + hstep + kstep, voffB);
        PG8_WAIT_V(6); PG8_BAR;
    } else {
        PG8_STAGE(PG8_SB(0, 0), cB, voffB); PG8_STAGE(PG8_SA(0, 0), cA, voffA); PG8_STAGE(PG8_SB(0, 1), cB + hstep, voffB); PG8_STAGE(PG8_SA(0, 1), cA + hstep, voffA);
        if (wr == 1) PG8_BAR;
        PG8_WAIT_V(4); PG8_BAR;
        PG8_STAGE(PG8_SB(1, 0), cB + kstep, voffB); PG8_STAGE(PG8_SA(1, 0), cA + kstep, voffA); PG8_STAGE(PG8_SB(1, 1), cB + hstep + kstep, voffB);
        PG8_WAIT_V(6); PG8_BAR;
    }
    for (;;) {
        const bool has_next = S.next(ui + 1, nxt);
        const char* nA = has_next ? (const char*)g.A + (size_t)nxt.pm * tstep : cA; const char* nB = has_next ? (const char*)g.Bt + (size_t)nxt.pn * tstep : cB;
        for (int t = 0; t < nt; t += 2) {
            const bool last = (t == nt - 2);
            const char* a1 = cA + (size_t)(t + 1) * kstep;
            const char* a2 = last ? nA : cA + (size_t)(t + 2) * kstep; const char* b2 = last ? nB : cB + (size_t)(t + 2) * kstep;
            const char* a3 = a2 + kstep; const char* b3 = b2 + kstep;
            if (last && has_next) S.a_ready(nxt);
            if constexpr (SP2) {
            PG8_LDB(B0, 0, 0); PG8_LDB(B1, 0, 1); PG8_SCHED; PG8_LDA(At, 0, 0); PG8_STAGE(PG8_SA(1, 1), a1 + hstep, voffA);
            PG8_WAIT_V(8); PG8_WAIT_L(0); PG8_BAR; PG8_MMA(0, 0, At, B0); PG8_MMA(0, 1, At, B1); PG8_BAR; PG8_SCHED;
            PG8_LDA(At, 0, 1); PG8_STAGE(PG8_SB(0, 0), b2, voffB); PG8_STAGE(PG8_SB(0, 1), b2 + hstep, voffB); PG8_STAGE(PG8_SA(0, 0), a2, voffA);
            PG8_WAIT_V(8); PG8_WAIT_L(0); PG8_BAR; PG8_MMA(1, 0, At, B0); PG8_MMA(1, 1, At, B1); PG8_BAR; PG8_SCHED;
            PG8_LDB(B0, 1, 0); PG8_LDB(B1, 1, 1); PG8_SCHED; PG8_LDA(At, 1, 0); PG8_STAGE(PG8_SA(0, 1), a2 + hstep, voffA);
            PG8_WAIT_V(8); PG8_WAIT_L(0); PG8_BAR; PG8_MMA(0, 0, At, B0); PG8_MMA(0, 1, At, B1); PG8_BAR; PG8_SCHED;
            PG8_LDA(At, 1, 1); PG8_STAGE(PG8_SB(1, 0), b3, voffB); PG8_STAGE(PG8_SB(1, 1), b3 + hstep, voffB); PG8_STAGE(PG8_SA(1, 0), a3, voffA);
            PG8_WAIT_V(8); PG8_WAIT_L(0); PG8_BAR; PG8_MMA(1, 0, At, B0); PG8_MMA(1, 1, At, B1); PG8_BAR; PG8_SCHED;
            } else {
            PG8_LDB(B0, 0, 0); PG8_SCHED; PG8_LDA(At, 0, 0); PG8_STAGE(PG8_SA(1, 1), a1 + hstep, voffA);
            PG8_WAIT_L(8); PG8_BAR; PG8_WAIT_L(0); PG8_MMA(0, 0, At, B0); PG8_BAR; PG8_SCHED;
            PG8_LDB(B1, 0, 1); PG8_STAGE(PG8_SB(0, 0), b2, voffB);
            PG8_BAR; PG8_WAIT_L(0); PG8_MMA(0, 1, At, B1); PG8_BAR;
            PG8_LDA(At, 0, 1); PG8_STAGE(PG8_SA(0, 0), a2, voffA);
            PG8_BAR; PG8_WAIT_L(0); PG8_MMA(1, 0, At, B0); PG8_BAR; PG8_SCHED;
            PG8_STAGE(PG8_SB(0, 1), b2 + hstep, voffB);
            PG8_WAIT_V(6); PG8_BAR; PG8_MMA(1, 1, At, B1); PG8_BAR;
            PG8_LDB(B0, 1, 0); PG8_SCHED; PG8_LDA(At, 1, 0); PG8_STAGE(PG8_SA(0, 1), a2 + hstep, voffA);
            PG8_WAIT_L(8); PG8_BAR; PG8_WAIT_L(0); PG8_MMA(0, 0, At, B0); PG8_BAR; PG8_SCHED;
            PG8_LDB(B1, 1, 1); PG8_STAGE(PG8_SB(1, 0), b3, voffB);
            PG8_BAR; PG8_WAIT_L(0); PG8_MMA(0, 1, At, B1); PG8_BAR;
            PG8_LDA(At, 1, 1); PG8_STAGE(PG8_SA(1, 0), a3, voffA);
            PG8_BAR; PG8_WAIT_L(0); PG8_MMA(1, 0, At, B0); PG8_BAR; PG8_SCHED;
            PG8_STAGE(PG8_SB(1, 1), b3 + hstep, voffB);
            PG8_WAIT_V(6); PG8_BAR; PG8_MMA(1, 1, At, B1); PG8_BAR;
            }
        }
        if constexpr (ALIGN_EPI) { if (wr == 0) PG8_BAR; }
        if constexpr (!Epi::AFTER_DRAIN) { E(acc, cur, wr, wc, fr, fq); S.done(cur); }
        if (!has_next) break;
#pragma unroll
        for (int a = 0; a < 2; ++a)
#pragma unroll
            for (int b = 0; b < 2; ++b)
#pragma unroll
                for (int m = 0; m < 4; ++m)
#pragma unroll
                    for (int n = 0; n < 2; ++n) acc[a][b][m][n] = (f32x4){0.f, 0.f, 0.f, 0.f};
        cur = nxt; cA = nA; cB = nB; ++ui;
        if constexpr (ALIGN_EPI) { if (wr == 1) PG8_BAR; }
    }
    PG8_WAIT_V(0);
    if constexpr (!ALIGN_EPI) { if (wr == 0) PG8_BAR; }
    PG8_BAR;
    if constexpr (Epi::AFTER_DRAIN) { E.fused(acc, cur, wr, wc, fr, fq, lds, wid, lane); S.done(cur); }
#undef PG8_SA
#undef PG8_SB
#undef PG8_STAGE
#undef PG8_LDA
#undef PG8_LDB
#undef PG8_MMA
#undef PG8_WAIT_V
#undef PG8_WAIT_L
#undef PG8_BAR
#undef PG8_SCHED
}
}

#define LAS __attribute__((address_space(3)))
typedef unsigned short bf16;
typedef short bf16x8 __attribute__((ext_vector_type(8)));
typedef float f32x4 __attribute__((ext_vector_type(4)));
typedef float f32x2 __attribute__((ext_vector_type(2)));
typedef unsigned u32x4 __attribute__((ext_vector_type(4)));
typedef unsigned u32x2 __attribute__((ext_vector_type(2)));

constexpr int M = 32768, D = 1024, SEQ = 16384, DFF = 2816;
constexpr float LN_EPS = 1e-5f;
constexpr float ALPHA = 1.681792830507429f;
constexpr int NWAVES = 8;
constexpr int LDS_BYTES = 147456;
constexpr size_t HMiB = 524288;
constexpr size_t WS_WIN0 = 0, WS_WIN1 = 9 * HMiB, WS_WIN2 = 15 * HMiB, WS_WIN3 = 24 * HMiB;
constexpr size_t WS_WO = 38 * HMiB;
constexpr size_t WS_WF1 = 58 * HMiB;
constexpr size_t WS_WF2 = 146 * HMiB;
constexpr size_t WS_WKV = 190 * HMiB;
constexpr size_t WS_WSM = 198 * HMiB;
constexpr size_t WS_MEMB = 200 * HMiB;
constexpr size_t WS_KVM = 202 * HMiB;
constexpr size_t WS_XB = 208 * HMiB;
constexpr size_t WS_HB = 336 * HMiB;
constexpr size_t WS_BR = 688 * HMiB;
constexpr size_t WS_END = 848 * HMiB;

__constant__ unsigned char T5B[256] = {
15,15,15,15,15,15,15,15,15,15,15,15,15,15,15,15,15,15,15,15,15,15,15,15,15,15,15,15,15,15,15,15,15,15,15,15,15,15,15,15,15,15,15,15,15,15,15,15,15,15,15,15,15,15,15,15,15,15,15,15,15,15,15,15,15,15,15,15,15,15,15,15,15,15,15,15,15,15,15,15,15,15,15,15,15,15,15,15,15,15,15,15,15,15,15,15,15,15,15,15,15,14,14,14,14,14,14,14,14,14,14,14,14,14,14,14,14,14,14,14,14,14,14,14,14,14,14,14,13,13,13,13,13,13,13,13,13,13,13,13,13,13,13,13,13,13,12,12,12,12,12,12,12,12,12,12,12,12,12,12,11,11,11,11,11,11,11,11,11,10,10,10,10,10,10,10,9,9,9,9,8,8,8,8,7,6,5,4,3,2,1,0,17,18,19,20,21,22,23,24,24,24,24,25,25,25,25,26,26,26,26,26,26,26,27,27,27,27,27,27,27,27,27,28,28,28,28,28,28,28,28,28,28,28,28,28,28,29,29,29,29,29,29,29,29,29,29,29,29,29,29,29,29,29,29,0};

__device__ __forceinline__ float bflo(unsigned u) { return __uint_as_float(u << 16); }
__device__ __forceinline__ float bfhi(unsigned u) { return __uint_as_float(u & 0xffff0000u); }
__device__ __forceinline__ unsigned pk2(float lo, float hi) { return pg8::cvt_pk_bf16(lo, hi); }
__device__ __forceinline__ float fexp(float x) { return __builtin_amdgcn_exp2f(x * 1.4426950408889634f); }
__device__ __forceinline__ float frcp(float x) { return __builtin_amdgcn_rcpf(x); }
__device__ __forceinline__ float fsigm(float x) { return frcp(1.f + fexp(-x)); }
__device__ __forceinline__ float wave_sum(float v) {
#pragma unroll
    for (int o = 1; o < 64; o <<= 1) v += __shfl_xor(v, o);
    return v;
}
__device__ __forceinline__ float act1(int mode, float a, float b) {
    if (mode == 1) { const float t = 1.5957691216057308f * (a + 0.044715f * a * a * a); return a * fsigm(t); }
    if (mode == 2) return a * fsigm(b);
    if (mode == 3) return a * b;
    return a * fsigm(a) * b;
}

struct EpiAct {
    static constexpr bool PERM = true, AFTER_DRAIN = false;
    bf16* O; int ldc; int t1, t2, m0, m1, m2, c0, c1, c2;
    __device__ __forceinline__ void operator()(const f32x4 (&acc)[2][2][4][2], const pg8::Unit& u, int wr, int wc, int fr, int fq) const {
        const int pn = u.pn; int mode, dcol;
        if (pn < t1) { mode = m0; dcol = c0 + (m0 >= 2 ? 128 : 256) * pn; }
        else if (pn < t2) { mode = m1; dcol = c1 + (m1 >= 2 ? 128 : 256) * (pn - t1); }
        else { mode = m2; dcol = c2 + (m2 >= 2 ? 128 : 256) * (pn - t2); }
        const int row0 = u.pm * 256 + wr * 64 + fr, col0 = dcol + wc * 32 + 8 * fq;
        if (mode < 2) {
#pragma unroll
            for (int ai = 0; ai < 2; ++ai)
#pragma unroll
                for (int m = 0; m < 4; ++m) { bf16* rowp = O + (size_t)(row0 + ai * 128 + m * 16) * ldc + col0;
#pragma unroll
                    for (int bj = 0; bj < 2; ++bj) { f32x4 v0 = acc[ai][bj][m][0], v1 = acc[ai][bj][m][1];
                        if (mode == 1) {
#pragma unroll
                            for (int e = 0; e < 4; ++e) { v0[e] = act1(1, v0[e], 0.f); v1[e] = act1(1, v1[e], 0.f); } }
                        u32x4 w; w.x = pk2(v0[0], v0[1]); w.y = pk2(v0[2], v0[3]); w.z = pk2(v1[0], v1[1]); w.w = pk2(v1[2], v1[3]);
                        *(u32x4*)(rowp + bj * 128) = w; }
                    asm volatile("" ::: "memory"); }
        } else {
#pragma unroll
            for (int ai = 0; ai < 2; ++ai)
#pragma unroll
                for (int m = 0; m < 4; ++m) { bf16* rowp = O + (size_t)(row0 + ai * 128 + m * 16) * ldc + col0;
                    f32x4 v0, v1;
#pragma unroll
                    for (int e = 0; e < 4; ++e) { v0[e] = act1(mode, acc[ai][0][m][0][e], acc[ai][1][m][0][e]); v1[e] = act1(mode, acc[ai][0][m][1][e], acc[ai][1][m][1][e]); }
                    u32x4 w; w.x = pk2(v0[0], v0[1]); w.y = pk2(v0[2], v0[3]); w.z = pk2(v1[0], v1[1]); w.w = pk2(v1[2], v1[3]);
                    *(u32x4*)rowp = w; asm volatile("" ::: "memory"); }
        }
    }
};
struct EpiRes {
    static constexpr bool PERM = false, AFTER_DRAIN = false;
    const float* R; float* Y; float alpha;
    __device__ __forceinline__ void operator()(const f32x4 (&acc)[2][2][4][2], const pg8::Unit& u, int wr, int wc, int fr, int fq) const {
        const int col0 = u.pn * 256 + wc * 32 + 4 * fq;
#pragma unroll
        for (int ai = 0; ai < 2; ++ai)
#pragma unroll
            for (int m = 0; m < 4; ++m) { const size_t off = (size_t)(u.pm * 256 + ai * 128 + wr * 64 + m * 16 + fr) * D + col0;
#pragma unroll
                for (int bj = 0; bj < 2; ++bj)
#pragma unroll
                    for (int n = 0; n < 2; ++n) { const f32x4 rv = *(const f32x4*)(R + off + bj * 128 + n * 16); *(f32x4*)(Y + off + bj * 128 + n * 16) = rv * alpha + acc[ai][bj][m][n]; }
                asm volatile("" ::: "memory"); }
    }
};

struct Args { const float* in[25]; float* out; unsigned char* ws; };
#define LAUNDER_TID() int tid = threadIdx.x; asm volatile("" : "+v"(tid)); const int lane = tid & 63, wave = __builtin_amdgcn_readfirstlane(tid >> 6); (void)lane; (void)wave

__device__ __forceinline__ void transpose_item(const float* W, int K, int N, bf16* WT, int r0, int r1, int half, LAS float* scr, int item, int lane) {
    const int nblk = N / 32, kb = item / nblk, nb = item % nblk, k0 = 64 * kb, n0 = 32 * nb;
    int s0 = n0; if (n0 >= r0 && n0 < r1) { const int rp = n0 - r0; s0 = r0 + ((rp >> 7) & 1) * half + 128 * (rp >> 8) + (rp & 127); }
#pragma unroll 8
    for (int i = 0; i < 32; ++i) { const int kk = 2 * i + (lane >> 5); scr[kk * 33 + (lane & 31)] = W[(size_t)(k0 + kk) * N + s0 + (lane & 31)]; }
    asm volatile("s_waitcnt lgkmcnt(0)" ::: "memory");
    const int c = lane & 7;
#pragma unroll
    for (int j = 0; j < 4; ++j) { const int n = (lane >> 3) + 8 * j; const LAS float* s = scr + (8 * c) * 33 + n;
        u32x4 o; o.x = pk2(s[0 * 33], s[1 * 33]); o.y = pk2(s[2 * 33], s[3 * 33]); o.z = pk2(s[4 * 33], s[5 * 33]); o.w = pk2(s[6 * 33], s[7 * 33]);
        *(u32x4*)(WT + (size_t)(n0 + n) * K + k0 + 8 * c) = o; }
    asm volatile("s_waitcnt lgkmcnt(0)" ::: "memory");
}
__device__ __forceinline__ void transpose_weight(const float* W, int K, int N, bf16* WT, int r0, int r1, int half, LAS float* scr, int gw, int NGW, int& rot, int lane) {
    const int items = (K / 64) * (N / 32);
    for (int it = (gw + NGW - rot) % NGW; it < items; it += NGW) transpose_item(W, K, N, WT, r0, r1, half, scr, it, lane);
    rot = (rot + items) % NGW;
}
__device__ __forceinline__ void cvt_rows_bf16(const float* src, bf16* dst, size_t n8, size_t gt, size_t GT) {
    for (size_t i = gt; i < n8; i += GT) { const f32x4 a = ((const f32x4*)src)[2 * i], b = ((const f32x4*)src)[2 * i + 1];
        u32x4 o; o.x = pk2(a[0], a[1]); o.y = pk2(a[2], a[3]); o.z = pk2(b[0], b[1]); o.w = pk2(b[2], b[3]); ((u32x4*)dst)[i] = o; }
}
__device__ __forceinline__ void prologue(const Args& a, LAS unsigned char* lds) {
    LAUNDER_TID();
    unsigned char* ws = a.ws; const int G = gridDim.x;
    LAS float* scr = (LAS float*)(lds + wave * 16384);
    const int gw = blockIdx.x * NWAVES + wave, NGW = G * NWAVES; int rot = 0;
    const size_t win_off[4] = {WS_WIN0, WS_WIN1, WS_WIN2, WS_WIN3};
#pragma unroll
    for (int l = 0; l < 4; ++l) {
        const int winN = l == 0 ? 2304 : l == 1 ? 1536 : l == 2 ? 2304 : 3328;
        const float* win = l == 0 ? a.in[2] : l == 1 ? a.in[7] : l == 2 ? a.in[10] : a.in[15];
        const int r0 = l == 3 ? 1024 : 0, r1 = l == 2 ? 2048 : l == 3 ? 3072 : 0;
        transpose_weight(win, 1024, winN, (bf16*)(ws + win_off[l]), r0, r1, 1024, scr, gw, NGW, rot, lane);
        transpose_weight(a.in[18] + (size_t)l * 1280 * 1024, 1280, 1024, (bf16*)(ws + WS_WO) + (size_t)l * 1280 * 1024, 0, 0, 0, scr, gw, NGW, rot, lane);
        transpose_weight(a.in[21] + (size_t)l * 1024 * 5632, 1024, 5632, (bf16*)(ws + WS_WF1) + (size_t)l * 1024 * 5632, 0, 5632, 2816, scr, gw, NGW, rot, lane);
        transpose_weight(a.in[22] + (size_t)l * 2816 * 1024, 2816, 1024, (bf16*)(ws + WS_WF2) + (size_t)l * 2816 * 1024, 0, 0, 0, scr, gw, NGW, rot, lane);
        transpose_weight(a.in[17] + (size_t)l * 1024 * 512, 1024, 512, (bf16*)(ws + WS_WKV) + (size_t)l * 1024 * 512, 0, 0, 0, scr, gw, NGW, rot, lane);
    }
    const size_t gt = (size_t)blockIdx.x * 512 + tid, GT = (size_t)G * 512;
    cvt_rows_bf16(a.in[0], (bf16*)(ws + WS_XB), (size_t)M * D / 8, gt, GT);
    cvt_rows_bf16(a.in[1], (bf16*)(ws + WS_MEMB), (size_t)512 * 1024 / 8, gt, GT);
    { const float* wsrc = a.in[5]; bf16* wd = (bf16*)(ws + WS_WSM);
      for (size_t i = gt; i < 8 * 128 * 128; i += GT) { const int jj = (int)(i & 127), ii = (int)((i >> 7) & 127); const float v = ((jj >> 6) <= (ii >> 6)) ? wsrc[i] : 0.f; wd[i] = (bf16)(pk2(v, 0.f) & 0xffffu); } }
}

__device__ __forceinline__ void ln_phase(float* Y, bf16* XB, const float* gam, const float* bet) {
    LAUNDER_TID();
    const int gw = blockIdx.x * NWAVES + wave, NGW = gridDim.x * NWAVES;
    f32x4 g4[4], b4[4];
#pragma unroll
    for (int j = 0; j < 4; ++j) { g4[j] = ((const f32x4*)gam)[lane + 64 * j]; b4[j] = ((const f32x4*)bet)[lane + 64 * j]; }
    for (int m = gw; m < M; m += NGW) {
        f32x4* xr = (f32x4*)(Y + (size_t)m * D) + lane;
        f32x4 v[4]; float s = 0.f;
#pragma unroll
        for (int j = 0; j < 4; ++j) { v[j] = xr[64 * j]; s += (v[j][0] + v[j][1]) + (v[j][2] + v[j][3]); }
        const float mean = wave_sum(s) * (1.f / D); float s2 = 0.f;
#pragma unroll
        for (int j = 0; j < 4; ++j) { v[j] = v[j] - mean; s2 += (v[j][0] * v[j][0] + v[j][1] * v[j][1]) + (v[j][2] * v[j][2] + v[j][3] * v[j][3]); }
        const float rstd = 1.f / sqrtf(wave_sum(s2) * (1.f / D) + LN_EPS);
        u32x2* o8 = (u32x2*)(XB + (size_t)m * D) + lane;
#pragma unroll
        for (int j = 0; j < 4; ++j) { const f32x4 o = v[j] * rstd * g4[j] + b4[j]; xr[64 * j] = o; u32x2 w; w.x = pk2(o[0], o[1]); w.y = pk2(o[2], o[3]); o8[64 * j] = w; }
    }
}

template <int NKT, bool SWA>
__device__ __forceinline__ void attn_tile16(const bf16* q, int ldq, const LAS bf16* KL, const LAS bf16* VT, int vts, const LAS float* btab, int qc0, float sink, int kt_first, bf16* o, int ldo, int lane) {
    const int fr = lane & 15, fq = lane >> 4;
    const bf16x8 qf0 = *(const bf16x8*)(q + (size_t)fr * ldq + 8 * fq), qf1 = *(const bf16x8*)(q + (size_t)fr * ldq + 32 + 8 * fq);
    f32x4 s[NKT];
#pragma unroll
    for (int kt = 0; kt < NKT; ++kt) {
        const LAS bf16* kp = KL + (16 * kt + fr) * 72 + 8 * fq;
        const bf16x8 k0 = *(const LAS bf16x8*)kp, k1 = *(const LAS bf16x8*)(kp + 32);
        f32x4 z = {0.f, 0.f, 0.f, 0.f};
        z = __builtin_amdgcn_mfma_f32_16x16x32_bf16(k0, qf0, z, 0, 0, 0);
        s[kt] = __builtin_amdgcn_mfma_f32_16x16x32_bf16(k1, qf1, z, 0, 0, 0);
    }
    float mx = SWA ? sink : -3.0e38f;
#pragma unroll
    for (int kt = 0; kt < NKT; ++kt) {
        if (!SWA || kt >= kt_first) {
#pragma unroll
            for (int e = 0; e < 4; ++e) { float v = s[kt][e] * 0.125f; if (SWA) v += btab[16 * kt + 4 * fq + e - (qc0 + fr) + 63]; s[kt][e] = v; mx = fmaxf(mx, v); }
        }
    }
    mx = fmaxf(mx, __shfl_xor(mx, 16)); mx = fmaxf(mx, __shfl_xor(mx, 32));
    float sum = 0.f;
#pragma unroll
    for (int kt = 0; kt < NKT; ++kt) {
        if (!SWA || kt >= kt_first) {
#pragma unroll
            for (int e = 0; e < 4; ++e) { const float p = fexp(s[kt][e] - mx); s[kt][e] = p; sum += p; }
        } else s[kt] = (f32x4){0.f, 0.f, 0.f, 0.f};
    }
    sum += __shfl_xor(sum, 16); sum += __shfl_xor(sum, 32);
    if (SWA) sum += fexp(sink - mx);
    const float inv = 1.f / sum;
    f32x4 oa[4];
#pragma unroll
    for (int dt = 0; dt < 4; ++dt) oa[dt] = (f32x4){0.f, 0.f, 0.f, 0.f};
#pragma unroll
    for (int t = 0; t < NKT / 2; ++t) {
        u32x4 pw; pw.x = pk2(s[2 * t][0], s[2 * t][1]); pw.y = pk2(s[2 * t][2], s[2 * t][3]); pw.z = pk2(s[2 * t + 1][0], s[2 * t + 1][1]); pw.w = pk2(s[2 * t + 1][2], s[2 * t + 1][3]);
        const bf16x8 pf = __builtin_bit_cast(bf16x8, pw);
#pragma unroll
        for (int dt = 0; dt < 4; ++dt) {
            const LAS bf16* vp = VT + (16 * dt + fr) * vts + 32 * t + 4 * fq;
            const u32x2 lo = *(const LAS u32x2*)vp, hi = *(const LAS u32x2*)(vp + 16);
            u32x4 vw; vw.x = lo.x; vw.y = lo.y; vw.z = hi.x; vw.w = hi.y;
            oa[dt] = __builtin_amdgcn_mfma_f32_16x16x32_bf16(__builtin_bit_cast(bf16x8, vw), pf, oa[dt], 0, 0, 0);
        }
    }
#pragma unroll
    for (int dt = 0; dt < 4; ++dt) { u32x2 w; w.x = pk2(oa[dt][0] * inv, oa[dt][1] * inv); w.y = pk2(oa[dt][2] * inv, oa[dt][3] * inv); *(u32x2*)(o + (size_t)fr * ldo + 16 * dt + 4 * fq) = w; }
}

__device__ __forceinline__ void swa_phase(const Args& a, LAS unsigned char* lds) {
    LAUNDER_TID();
    const bf16* H = (const bf16*)(a.ws + WS_HB); bf16* BR = (bf16*)(a.ws + WS_BR);
    LAS bf16* KL = (LAS bf16*)lds; LAS bf16* VT = (LAS bf16*)(lds + 27648); LAS unsigned* VTd = (LAS unsigned*)(lds + 27648); LAS float* BT = (LAS float*)(lds + 53248);
    const float* sinks = a.in[8]; const float* relb = a.in[9];
    for (int unit = blockIdx.x; unit < 1024; unit += gridDim.x) {
        const int kvh = unit & 1, n = (unit >> 1) & 255, b = unit >> 9;
        const int rowq0 = b * SEQ + 64 * n, rowk0 = rowq0 - 128, kt_first = n >= 2 ? 0 : (n == 1 ? 4 : 8);
#pragma unroll
        for (int i = 0; i < 3; ++i) { const int q = tid + 512 * i, row = q >> 3, ch = q & 7; u32x4 v = {0u, 0u, 0u, 0u};
            if (row >= 16 * kt_first) v = *(const u32x4*)(H + (size_t)(rowk0 + row) * 1536 + 1024 + kvh * 64 + 8 * ch);
            *(LAS u32x4*)(KL + row * 72 + 8 * ch) = v; }
        for (int q = tid; q < 768; q += 512) { const int ch = q & 7, kp = q >> 3; u32x4 v0 = {0u, 0u, 0u, 0u}, v1 = {0u, 0u, 0u, 0u};
            if (2 * kp >= 16 * kt_first) { const bf16* p = H + (size_t)(rowk0 + 2 * kp) * 1536 + 1152 + kvh * 64 + 8 * ch; v0 = *(const u32x4*)p; v1 = *(const u32x4*)(p + 1536); }
#pragma unroll
            for (int e = 0; e < 4; ++e) { const unsigned x0 = v0[e], x1 = v1[e];
                VTd[(8 * ch + 2 * e) * 100 + kp] = (x0 & 0xffffu) | (x1 << 16);
                VTd[(8 * ch + 2 * e + 1) * 100 + kp] = (x0 >> 16) | (x1 & 0xffff0000u); } }
#pragma unroll
        for (int i = 0; i < 4; ++i) { const int q = tid + 512 * i, g = q >> 8, idx = q & 255; BT[q] = relb[(int)T5B[idx] * 16 + kvh * 8 + g]; }
        __syncthreads();
        const int h = kvh * 8 + wave; const float sink = sinks[h];
        for (int rt = 0; rt < 4; ++rt)
            attn_tile16<12, true>(H + (size_t)(rowq0 + 16 * rt) * 1536 + h * 64, 1536, KL, VT, 200, BT + wave * 256, 16 * rt, sink, kt_first, BR + (size_t)(rowq0 + 16 * rt) * 1280 + h * 64, 1280, lane);
        __syncthreads();
    }
}

__device__ __forceinline__ void xattn_phase(const Args& a, int layer, int ldh, int qxoff, LAS unsigned char* lds) {
    LAUNDER_TID();
    const bf16* H = (const bf16*)(a.ws + WS_HB); bf16* BR = (bf16*)(a.ws + WS_BR); const bf16* KVM = (const bf16*)(a.ws + WS_KVM) + (size_t)layer * 512 * 512;
    LAS bf16* KL = (LAS bf16*)lds; LAS bf16* VT = (LAS bf16*)(lds + 36864); LAS unsigned* VTd = (LAS unsigned*)(lds + 36864);
    for (int unit = blockIdx.x; unit < 256; unit += gridDim.x) {
        const int xh = unit & 3, rb = (unit >> 2) & 31, b = unit >> 7;
        const int rows0 = b * SEQ + 512 * rb;
#pragma unroll
        for (int i = 0; i < 4; ++i) { const int q = tid + 512 * i, row = q >> 3, ch = q & 7;
            *(LAS u32x4*)(KL + row * 72 + 8 * ch) = *(const u32x4*)(KVM + (size_t)(b * 256 + row) * 512 + xh * 64 + 8 * ch); }
#pragma unroll
        for (int i = 0; i < 2; ++i) { const int q = tid + 512 * i, ch = q & 7, kp = q >> 3;
            const bf16* p = KVM + (size_t)(b * 256 + 2 * kp) * 512 + 256 + xh * 64 + 8 * ch; const u32x4 v0 = *(const u32x4*)p, v1 = *(const u32x4*)(p + 512);
#pragma unroll
            for (int e = 0; e < 4; ++e) { const unsigned x0 = v0[e], x1 = v1[e];
                VTd[(8 * ch + 2 * e) * 164 + kp] = (x0 & 0xffffu) | (x1 << 16);
                VTd[(8 * ch + 2 * e + 1) * 164 + kp] = (x0 >> 16) | (x1 & 0xffff0000u); } }
        __syncthreads();
        for (int rt = wave; rt < 32; rt += 8)
            attn_tile16<16, false>(H + (size_t)(rows0 + 16 * rt) * ldh + qxoff + xh * 64, ldh, KL, VT, 328, nullptr, 0, 0.f, 0, BR + (size_t)(rows0 + 16 * rt) * 1280 + 1024 + xh * 64, 1280, lane);
        __syncthreads();
    }
}

__device__ __forceinline__ void sgu_phase(const Args& a, LAS unsigned char* lds) {
    LAUNDER_TID();
    const bf16* H = (const bf16*)(a.ws + WS_HB); bf16* BR = (bf16*)(a.ws + WS_BR); const bf16* WSM = (const bf16*)(a.ws + WS_WSM);
    LAS float* stat = (LAS float*)lds; LAS unsigned* VTd = (LAS unsigned*)(lds + 1024); LAS bf16* WL = (LAS bf16*)(lds + 1024 + 34816);
    const float* gam = a.in[3]; const float* bet = a.in[4]; const float* bs = a.in[6];
    const int fr = lane & 15, fq = lane >> 4;
    for (int nb = blockIdx.x; nb < 256; nb += gridDim.x) {
        const int r0 = 128 * nb;
        for (int rr = 0; rr < 16; ++rr) { const int row = 16 * wave + rr; const u32x4* p = (const u32x4*)(H + (size_t)(r0 + row) * 2304 + 1024);
            const u32x4 v0 = p[lane], v1 = p[lane + 64]; float x[16];
#pragma unroll
            for (int e = 0; e < 4; ++e) { x[2 * e] = bflo(v0[e]); x[2 * e + 1] = bfhi(v0[e]); x[8 + 2 * e] = bflo(v1[e]); x[9 + 2 * e] = bfhi(v1[e]); }
            float s = 0.f;
#pragma unroll
            for (int e = 0; e < 16; ++e) s += x[e];
            const float mean = wave_sum(s) * (1.f / 1024.f); float s2 = 0.f;
#pragma unroll
            for (int e = 0; e < 16; ++e) { const float d = x[e] - mean; s2 += d * d; }
            const float rstd = 1.f / sqrtf(wave_sum(s2) * (1.f / 1024.f) + LN_EPS);
            if (lane == 0) { stat[2 * row] = mean; stat[2 * row + 1] = rstd; } }
        __syncthreads();
        for (int g = 0; g < 8; ++g) {
#pragma unroll
            for (int i2 = 0; i2 < 2; ++i2) { const int q = tid + 512 * i2, cc = q & 15, jp = q >> 4, j0 = 2 * jp;
                const bf16* p = H + (size_t)(r0 + j0) * 2304 + 1024 + 128 * g + 8 * cc; const u32x4 A0 = *(const u32x4*)p, A1 = *(const u32x4*)(p + 2304);
                const float m0 = stat[2 * j0], rs0 = stat[2 * j0 + 1], m1 = stat[2 * j0 + 2], rs1 = stat[2 * j0 + 3];
                const f32x4 ga0 = *(const f32x4*)(gam + 128 * g + 8 * cc), ga1 = *(const f32x4*)(gam + 128 * g + 8 * cc + 4), be0 = *(const f32x4*)(bet + 128 * g + 8 * cc), be1 = *(const f32x4*)(bet + 128 * g + 8 * cc + 4);
#pragma unroll
                for (int e = 0; e < 4; ++e) { const float gl = e < 2 ? ga0[2 * e] : ga1[2 * e - 4], gh = e < 2 ? ga0[2 * e + 1] : ga1[2 * e - 3], bl = e < 2 ? be0[2 * e] : be1[2 * e - 4], bh = e < 2 ? be0[2 * e + 1] : be1[2 * e - 3];
                    const float y0l = (bflo(A0[e]) - m0) * rs0 * gl + bl, y1l = (bflo(A1[e]) - m1) * rs1 * gl + bl, y0h = (bfhi(A0[e]) - m0) * rs0 * gh + bh, y1h = (bfhi(A1[e]) - m1) * rs1 * gh + bh;
                    VTd[(8 * cc + 2 * e) * 68 + (jp ^ (4 * cc))] = pk2(y0l, y1l);
                    VTd[(8 * cc + 2 * e + 1) * 68 + (jp ^ (4 * cc))] = pk2(y0h, y1h); } }
#pragma unroll
            for (int i4 = 0; i4 < 4; ++i4) { const int q = tid + 512 * i4, row = q >> 4, ch = q & 15;
                *(LAS u32x4*)(WL + row * 136 + 8 * ch) = *(const u32x4*)(WSM + (size_t)(g * 128 + row) * 128 + 8 * ch); }
            __syncthreads();
            const int c = 16 * wave + fr; bf16x8 af[4];
#pragma unroll
            for (int kk = 0; kk < 4; ++kk) af[kk] = *(const LAS bf16x8*)(VTd + c * 68 + ((16 * kk + 4 * fq) ^ (4 * ((c >> 3) & 15))));
#pragma unroll
            for (int it = 0; it < 8; ++it) { f32x4 acc = {0.f, 0.f, 0.f, 0.f};
#pragma unroll
                for (int kk = 0; kk < 4; ++kk) if (it >= 4 || kk < 2) { const bf16x8 bfr = *(const LAS bf16x8*)(WL + (16 * it + fr) * 136 + 32 * kk + 8 * fq); acc = __builtin_amdgcn_mfma_f32_16x16x32_bf16(af[kk], bfr, acc, 0, 0, 0); }
                const int i = 16 * it + fr, col = 128 * g + 16 * wave + 4 * fq; const float bias = bs[g * 128 + i];
                const u32x2 uu = *(const u32x2*)(H + (size_t)(r0 + i) * 2304 + col);
                u32x2 w; w.x = pk2(bflo(uu.x) * (acc[0] + bias), bfhi(uu.x) * (acc[1] + bias)); w.y = pk2(bflo(uu.y) * (acc[2] + bias), bfhi(uu.y) * (acc[3] + bias));
                *(u32x2*)(BR + (size_t)(r0 + i) * 1280 + col) = w; }
            __syncthreads();
        }
    }
}

__device__ __forceinline__ void conv31_phase(const Args& a, LAS unsigned char* lds) {
    LAUNDER_TID();
    const bf16* H = (const bf16*)(a.ws + WS_HB); bf16* BR = (bf16*)(a.ws + WS_BR);
    const float* cw = a.in[11]; const float* cb = a.in[12]; const float* lg = a.in[13]; const float* lb = a.in[14];
    LAS float* red = (LAS float*)lds; LAS float* tot = (LAS float*)(lds + 65536);
    const int c0 = 2 * tid;
    const f32x2 cbv = *(const f32x2*)(cb + c0), lgv = *(const f32x2*)(lg + c0), lbv = *(const f32x2*)(lb + c0);
    for (int strip = blockIdx.x; strip < M / 16; strip += gridDim.x) {
        const int R0 = 16 * strip, tseq = R0 & (SEQ - 1);
        float xl[46], xh[46];
#pragma unroll
        for (int i = 0; i < 46; ++i) { unsigned pk = 0u; if (tseq - 30 + i >= 0) pk = ((const unsigned*)(H + (size_t)(R0 - 30 + i) * 1280))[tid]; xl[i] = bflo(pk); xh[i] = bfhi(pk); }
        float al[16], ah[16];
#pragma unroll
        for (int o = 0; o < 16; ++o) { al[o] = cbv.x; ah[o] = cbv.y; }
#pragma unroll
        for (int k = 0; k < 31; ++k) { const f32x2 wk = *(const f32x2*)(cw + k * 1024 + c0);
#pragma unroll
            for (int o = 0; o < 16; ++o) { al[o] += wk.x * xl[o + k]; ah[o] += wk.y * xh[o + k]; } }
#pragma unroll
        for (int o = 0; o < 16; ++o) { red[o * 512 + tid] = al[o] + ah[o]; red[(16 + o) * 512 + tid] = al[o] * al[o] + ah[o] * ah[o]; }
        __syncthreads();
        { const int v = tid >> 4, l = tid & 15; float s = 0.f;
#pragma unroll
          for (int i = 0; i < 32; ++i) s += red[v * 512 + i * 16 + l];
          s += __shfl_xor(s, 1); s += __shfl_xor(s, 2); s += __shfl_xor(s, 4); s += __shfl_xor(s, 8);
          if (l == 0) tot[v] = s; }
        __syncthreads();
#pragma unroll
        for (int o = 0; o < 16; ++o) { const float mean = tot[o] * (1.f / 1024.f), var = tot[16 + o] * (1.f / 1024.f) - mean * mean, rstd = 1.f / sqrtf(fmaxf(var, 0.f) + LN_EPS);
            const float yl = (al[o] - mean) * rstd * lgv.x + lbv.x, yh = (ah[o] - mean) * rstd * lgv.y + lbv.y;
            ((unsigned*)(BR + (size_t)(R0 + o) * 1280))[tid] = pk2(yl * fsigm(yl), yh * fsigm(yh)); }
        __syncthreads();
    }
}

__device__ __forceinline__ void conv3_phase(const Args& a) {
    LAUNDER_TID();
    const bf16* H = (const bf16*)(a.ws + WS_HB); bf16* BR = (bf16*)(a.ws + WS_BR); const float* w = a.in[16];
    const size_t gt = (size_t)blockIdx.x * 512 + tid, GT = (size_t)gridDim.x * 512;
    for (size_t it = gt; it < (size_t)M * 128; it += GT) { const int row = (int)(it >> 7), ch = (int)(it & 127), tseq = row & (SEQ - 1);
        const bf16* hp = H + (size_t)row * 2304 + 8 * ch;
        const u32x4 bg = *(const u32x4*)hp, p2 = *(const u32x4*)(hp + 1024);
        u32x4 p1 = {0u, 0u, 0u, 0u}, p0 = {0u, 0u, 0u, 0u};
        if (tseq >= 1) p1 = *(const u32x4*)(hp + 1024 - 2304);
        if (tseq >= 2) p0 = *(const u32x4*)(hp + 1024 - 4608);
        const f32x4 w0a = *(const f32x4*)(w + 8 * ch), w0b = *(const f32x4*)(w + 8 * ch + 4), w1a = *(const f32x4*)(w + 1024 + 8 * ch), w1b = *(const f32x4*)(w + 1024 + 8 * ch + 4), w2a = *(const f32x4*)(w + 2048 + 8 * ch), w2b = *(const f32x4*)(w + 2048 + 8 * ch + 4);
        u32x4 o;
#pragma unroll
        for (int e = 0; e < 4; ++e) { const float k0l = e < 2 ? w0a[2 * e] : w0b[2 * e - 4], k0h = e < 2 ? w0a[2 * e + 1] : w0b[2 * e - 3], k1l = e < 2 ? w1a[2 * e] : w1b[2 * e - 4], k1h = e < 2 ? w1a[2 * e + 1] : w1b[2 * e - 3], k2l = e < 2 ? w2a[2 * e] : w2b[2 * e - 4], k2h = e < 2 ? w2a[2 * e + 1] : w2b[2 * e - 3];
            const float yl = bflo(bg[e]) * (k0l * bflo(p0[e]) + k1l * bflo(p1[e]) + k2l * bflo(p2[e])), yh = bfhi(bg[e]) * (k0h * bfhi(p0[e]) + k1h * bfhi(p1[e]) + k2h * bfhi(p2[e]));
            o[e] = pk2(yl, yh); }
        *(u32x4*)(BR + (size_t)row * 1280 + 8 * ch) = o; }
}

__global__ void __launch_bounds__(512, 2) fwd_megakernel(Args a) {
    extern __shared__ __attribute__((aligned(16))) unsigned char lds_raw[];
    LAS unsigned char* lds = (LAS unsigned char*)lds_raw;
    cg::grid_group grid = cg::this_grid();
    const int G = gridDim.x;
    unsigned char* ws = a.ws;
    bf16* XB = (bf16*)(ws + WS_XB); bf16* HB = (bf16*)(ws + WS_HB); bf16* BR = (bf16*)(ws + WS_BR);

    prologue(a, lds);
    grid.sync();

    for (int layer = 0; layer < 4; ++layer) {
        {
            const int N = layer == 0 ? 2304 : layer == 1 ? 1536 : layer == 2 ? 2304 : 3328;
            const size_t woff = layer == 0 ? WS_WIN0 : layer == 1 ? WS_WIN1 : layer == 2 ? WS_WIN2 : WS_WIN3;
            EpiAct E;
            E.O = HB;
            if (layer == 0)      { E.ldc = 2304; E.t1 = 8; E.t2 = 9;  E.m0 = 1; E.m1 = 0; E.m2 = 0; E.c0 = 0; E.c1 = 2048; E.c2 = 0; }
            else if (layer == 1) { E.ldc = 1536; E.t1 = 6; E.t2 = 6;  E.m0 = 0; E.m1 = 0; E.m2 = 0; E.c0 = 0; E.c1 = 0;    E.c2 = 0; }
            else if (layer == 2) { E.ldc = 1280; E.t1 = 8; E.t2 = 9;  E.m0 = 2; E.m1 = 0; E.m2 = 0; E.c0 = 0; E.c1 = 1024; E.c2 = 0; }
            else                 { E.ldc = 2304; E.t1 = 4; E.t2 = 12; E.m0 = 0; E.m1 = 3; E.m2 = 0; E.c0 = 0; E.c1 = 1024; E.c2 = 2048; }
            pg8::Gemm g{XB, (const bf16*)(ws + woff), M, N, 1024}; pg8::StaticOrder S; S.init(M, N, G, (int)blockIdx.x);
            pg8::gemm_phase<EpiAct, pg8::StaticOrder, true, true>(lds, g, S, E);
            if (layer == 0) {
                for (int l = 0; l < 4; ++l) {
                    EpiAct E2; E2.O = (bf16*)(ws + WS_KVM) + (size_t)l * 512 * 512; E2.ldc = 512; E2.t1 = 2; E2.t2 = 2; E2.m0 = 0; E2.m1 = 0; E2.m2 = 0; E2.c0 = 0; E2.c1 = 0; E2.c2 = 0;
                    pg8::Gemm g2{(const bf16*)(ws + WS_MEMB), (const bf16*)(ws + WS_WKV) + (size_t)l * 512 * 1024, 512, 512, 1024};
                    pg8::StaticOrder S2; S2.init(512, 512, G, (int)((blockIdx.x + G - (128 + 4 * l) % G) % G));
                    pg8::gemm_phase<EpiAct, pg8::StaticOrder, true, true>(lds, g2, S2, E2);
                }
            }
        }
        grid.sync();
        if (layer == 0)      sgu_phase(a, lds);
        else if (layer == 1) swa_phase(a, lds);
        else if (layer == 2) conv31_phase(a, lds);
        else                 conv3_phase(a);
        xattn_phase(a, layer, layer == 1 ? 1536 : layer == 2 ? 1280 : 2304, layer == 1 ? 1280 : layer == 2 ? 1024 : 2048, lds);
        grid.sync();
        {
            EpiRes E{layer == 0 ? a.in[0] : a.out, a.out, ALPHA};
            pg8::Gemm g{BR, (const bf16*)(ws + WS_WO) + (size_t)layer * 1280 * 1024, M, 1024, 1280}; pg8::StaticOrder S; S.init(M, 1024, G, (int)blockIdx.x);
            pg8::gemm_phase<EpiRes, pg8::StaticOrder, true, true>(lds, g, S, E);
        }
        grid.sync();
        ln_phase(a.out, XB, a.in[19] + layer * D, a.in[20] + layer * D);
        grid.sync();
        {
            EpiAct E; E.O = HB; E.ldc = DFF; E.t1 = 22; E.t2 = 22; E.m0 = 4; E.m1 = 0; E.m2 = 0; E.c0 = 0; E.c1 = 0; E.c2 = 0;
            pg8::Gemm g{XB, (const bf16*)(ws + WS_WF1) + (size_t)layer * 5632 * 1024, M, 5632, 1024}; pg8::StaticOrder S; S.init(M, 5632, G, (int)blockIdx.x);
            pg8::gemm_phase<EpiAct, pg8::StaticOrder, true, true>(lds, g, S, E);
        }
        grid.sync();
        {
            EpiRes E{a.out, a.out, ALPHA};
            pg8::Gemm g{HB, (const bf16*)(ws + WS_WF2) + (size_t)layer * 2816 * 1024, M, 1024, 2816}; pg8::StaticOrder S; S.init(M, 1024, G, (int)blockIdx.x);
            pg8::gemm_phase<EpiRes, pg8::StaticOrder, true, true>(lds, g, S, E);
        }
        grid.sync();
        ln_phase(a.out, XB, a.in[23] + layer * D, a.in[24] + layer * D);
        if (layer < 3) grid.sync();
    }
}

extern "C" void kernel_launch(void* const* d_in, const int* in_sizes, int n_in, void* d_out, int out_size, void* d_ws, size_t ws_size, hipStream_t stream) {
    static int grid = 0;
    if (grid == 0) {
        if (n_in != 25 || out_size != M * D || ws_size < WS_END) { fprintf(stderr, "kernel_launch: unexpected problem (n_in %d, out %d, ws %zu)\n", n_in, out_size, ws_size); grid = -1; return; }
        int dev = 0, cus = 0, per_cu = 0;
        (void)hipGetDevice(&dev);
        (void)hipDeviceGetAttribute(&cus, hipDeviceAttributeMultiprocessorCount, dev);
        (void)hipFuncSetAttribute((const void*)fwd_megakernel, hipFuncAttributeMaxDynamicSharedMemorySize, LDS_BYTES);
        (void)hipOccupancyMaxActiveBlocksPerMultiprocessor(&per_cu, (const void*)fwd_megakernel, 512, LDS_BYTES);
        if (per_cu < 1) per_cu = 1;
        grid = cus * per_cu;
        (void)hipGetLastError();
    }
    if (grid < 0) return;
    Args a{};
    for (int i = 0; i < 25; ++i) a.in[i] = (const float*)d_in[i];
    a.out = (float*)d_out; a.ws = (unsigned char*)d_ws;
    void* args[] = {&a};
    hipError_t e = hipLaunchCooperativeKernel((const void*)fwd_megakernel, dim3(grid), dim3(512), args, LDS_BYTES, stream);
    if (e != hipSuccess) fprintf(stderr, "cooperative launch failed: %s (grid %d)\n", hipGetErrorString(e), grid);
}
```

```cpp
#include <hip/hip_runtime.h>
#include <hip/hip_cooperative_groups.h>
#include <cstdio>
#include <cstdint>
namespace cg = cooperative_groups;
namespace pg8 {
#define PG8_LAS __attribute__((address_space(3)))
typedef unsigned short bf16_t;
typedef short bf16x8 __attribute__((ext_vector_type(8)));
typedef float f32x4 __attribute__((ext_vector_type(4)));
typedef unsigned u32x4 __attribute__((ext_vector_type(4)));
constexpr int BM = 256, BK = 64, HALF = 128, HTB = HALF * BK * 2  , STAGE_BYTES = 8 * HTB, NXCD = 8, WGM = 8;

__host__ __device__ __forceinline__ int lds_byte(int r, int c) { const int st = (r >> 4) * 2 + (c >> 5), rr = r & 15, cc = c & 31, ob = rr * 64 + cc * 2; return st * 1024 + (ob ^ (((ob >> 9) & 1) << 5)); }
__host__ __device__ __forceinline__ void stage_rc(int b, int& R, int& C) { const int st = b / 1024, sb = b % 1024, swz = sb ^ (((sb >> 9) & 1) << 5); R = (st >> 1) * 16 + swz / 64; C = (st & 1) * 32 + (swz % 64) / 2; }
__host__ __device__ __forceinline__ int perm32(int rho) { const int n = rho >> 4, i = rho & 15; return 8 * (i >> 2) + 4 * n + (i & 3); }

struct Unit { int pm, pn; };
struct Gemm { const bf16_t* A; const bf16_t* Bt; int M, N, K; };

struct StaticOrder {
    int nM, nN, nwg, G, c;
    __host__ __device__ void init(int M, int N, int G_, int c_) { nM = M / BM; nN = N / BM; nwg = nM * nN; G = G_; c = c_; }
    __host__ __device__ bool next(int i, Unit& u) const {
        const long L = (long)i * G + c; if (L >= nwg) return false;
        int wgid = (int)L; { const int q = nwg / NXCD, r = nwg % NXCD, xcd = wgid % NXCD, off = wgid / NXCD; wgid = (xcd < r ? xcd * (q + 1) : r * (q + 1) + (xcd - r) * q) + off; }
        const int nig = WGM * nN, gid = wgid / nig, fm = gid * WGM, gsz = (nM - fm) < WGM ? (nM - fm) : WGM;
        u.pm = fm + ((wgid % nig) % gsz); u.pn = (wgid % nig) / gsz; return true;
    }
    __device__ __forceinline__ void a_ready(const Unit&) const {}
    __device__ __forceinline__ void done(const Unit&) const {}
};

__device__ __forceinline__ unsigned cvt_pk_bf16(float lo, float hi) { unsigned r; asm volatile("v_cvt_pk_bf16_f32 %0, %1, %2" : "=v"(r) : "v"(lo), "v"(hi)); return r; }
template <class Epi, class Sched, bool ALIGN_EPI = false, bool SP2 = false>
__device__ __forceinline__ void gemm_phase(PG8_LAS unsigned char* lds, const Gemm g, const Sched& S, const Epi& E) {
    int tid_l = threadIdx.x; asm volatile("" : "+v"(tid_l));
    const int tid = tid_l, wid = __builtin_amdgcn_readfirstlane(tid >> 6), lane = tid & 63, wr = wid >> 2, wc = wid & 3, fr = lane & 15, fq = lane >> 4;
    const int K = g.K, nt = K / BK;
    unsigned voffA[2], voffB[2];
#pragma unroll
    for (int i = 0; i < 2; ++i) { int R, C; stage_rc(tid * 16 + i * 8192, R, C); const int Rb = Epi::PERM ? ((R & ~31) + perm32(R & 31)) : R;
        voffA[i] = (unsigned)(R * K + C) * 2u; voffB[i] = (unsigned)(Rb * K + C) * 2u; }
    const size_t kstep = (size_t)(BK * 2);
    const size_t hstep = (size_t)HALF * K * 2;
    const size_t tstep = 2 * hstep;
    const unsigned ldsw = (unsigned)wid * 1024u;
    const int aoff = lds_byte(wr * 64 + fr, fq * 8), boff = lds_byte(wc * 32 + fr, fq * 8);
#define PG8_SA(b, h) (((b) * 2 + (h)) * HTB)
#define PG8_SB(b, h) ((4 + (b) * 2 + (h)) * HTB)
#define PG8_STAGE(bufoff, gbase, voff) do { _Pragma("unroll") for (int _i = 0; _i < 2; ++_i) \
        __builtin_amdgcn_global_load_lds((const unsigned*)((const char*)(gbase) + (voff)[_i]), (PG8_LAS unsigned*)(lds + (bufoff) + ldsw + _i * 8192), 16, 0, 0); } while (0)
#define PG8_LDA(dst, b, h) do { _Pragma("unroll") for (int m = 0; m < 4; ++m) _Pragma("unroll") for (int k = 0; k < 2; ++k) dst[m][k] = *(const PG8_LAS bf16x8*)(lds + PG8_SA(b, h) + aoff + m * 2048 + k * 1024); } while (0)
#define PG8_LDB(dst, b, h) do { _Pragma("unroll") for (int n = 0; n < 2; ++n) _Pragma("unroll") for (int k = 0; k < 2; ++k) dst[n][k] = *(const PG8_LAS bf16x8*)(lds + PG8_SB(b, h) + boff + n * 2048 + k * 1024); } while (0)
#define PG8_MMA(ai, bj, At, Bt) do { __builtin_amdgcn_s_setprio(1); _Pragma("unroll") for (int m = 0; m < 4; ++m) _Pragma("unroll") for (int n = 0; n < 2; ++n) _Pragma("unroll") for (int k = 0; k < 2; ++k) \
        acc[ai][bj][m][n] = __builtin_amdgcn_mfma_f32_16x16x32_bf16(Bt[n][k], At[m][k], acc[ai][bj][m][n], 0, 0, 0); __builtin_amdgcn_s_setprio(0); } while (0)
#define PG8_WAIT_V(n) asm volatile("s_waitcnt vmcnt(" #n ")" ::: "memory")
#define PG8_WAIT_L(n) asm volatile("s_waitcnt lgkmcnt(" #n ")" ::: "memory")
#define PG8_BAR __builtin_amdgcn_s_barrier()
#define PG8_SCHED __builtin_amdgcn_sched_barrier(0)
    Unit cur, nxt; int ui = 0;
    if (!S.next(0, cur)) return;
    f32x4 acc[2][2][4][2];
#pragma unroll
    for (int a = 0; a < 2; ++a)
#pragma unroll
        for (int b = 0; b < 2; ++b)
#pragma unroll
            for (int m = 0; m < 4; ++m)
#pragma unroll
                for (int n = 0; n < 2; ++n) acc[a][b][m][n] = (f32x4){0.f, 0.f, 0.f, 0.f};
    bf16x8 At[4][2], B0[2][2], B1[2][2];
    const char* cA = (const char*)g.A + (size_t)cur.pm * tstep; const char* cB = (const char*)g.Bt + (size_t)cur.pn * tstep;
    S.a_ready(cur);
    if constexpr (SP2) {
        PG8_STAGE(PG8_SB(0, 0), cB, voffB); PG8_STAGE(PG8_SB(0, 1), cB + hstep, voffB); PG8_STAGE(PG8_SA(0, 0), cA, voffA); PG8_STAGE(PG8_SA(0, 1), cA + hstep, voffA);
        if (wr == 1) PG8_BAR;
        PG8_WAIT_V(2); PG8_BAR;
        PG8_STAGE(PG8_SB(1, 0), cB + kstep, voffB); PG8_STAGE(PG8_SA(1, 0), cA + kstep, voffA); PG8_STAGE(PG8_SB(1, 1), cB + hstep + kstep, voffB);
        PG8_WAIT_V(6); PG8_BAR;
    } else {
        PG8_STAGE(PG8_SB(0, 0), cB, voffB); PG8_STAGE(PG8_SA(0, 0), cA, voffA); PG8_STAGE(PG8_SB(0, 1), cB + hstep, voffB); PG8_STAGE(PG8_SA(0, 1), cA + hstep, voffA);
        if (wr == 1) PG8_BAR;
        PG8_WAIT_V(4); PG8_BAR;
        PG8_STAGE(PG8_SB(1, 0), cB + kstep, voffB); PG8_STAGE(PG8_SA(1, 0), cA + kstep, voffA); PG8_STAGE(PG8_SB(1, 1), cB + hstep + kstep, voffB);
        PG8_WAIT_V(6); PG8_BAR;
    }
    for (;;) {
        const bool has_next = S.next(ui + 1, nxt);
        const char* nA = has_next ? (const char*)g.A + (size_t)nxt.pm * tstep : cA; const char* nB = has_next ? (const char*)g.Bt + (size_t)nxt.pn * tstep : cB;
        for (int t = 0; t < nt; t += 2) {
            const bool last = (t == nt - 2);
            const char* a1 = cA + (size_t)(t + 1) * kstep;
            const char* a2 = last ? nA : cA + (size_t)(t + 2) * kstep; const char* b2 = last ? nB : cB + (size_t)(t + 2) * kstep;
            const char* a3 = a2 + kstep; const char* b3 = b2 + kstep;
            if (last && has_next) S.a_ready(nxt);
            if constexpr (SP2) {
            PG8_LDB(B0, 0, 0); PG8_LDB(B1, 0, 1); PG8_SCHED; PG8_LDA(At, 0, 0); PG8_STAGE(PG8_SA(1, 1), a1 + hstep, voffA);
            PG8_WAIT_V(8); PG8_WAIT_L(0); PG8_BAR; PG8_MMA(0, 0, At, B0); PG8_MMA(0, 1, At, B1); PG8_BAR; PG8_SCHED;
            PG8_LDA(At, 0, 1); PG8_STAGE(PG8_SB(0, 0), b2, voffB); PG8_STAGE(PG8_SB(0, 1), b2 + hstep, voffB); PG8_STAGE(PG8_SA(0, 0), a2, voffA);
            PG8_WAIT_V(8); PG8_WAIT_L(0); PG8_BAR; PG8_MMA(1, 0, At, B0); PG8_MMA(1, 1, At, B1); PG8_BAR; PG8_SCHED;
            PG8_LDB(B0, 1, 0); PG8_LDB(B1, 1, 1); PG8_SCHED; PG8_LDA(At, 1, 0); PG8_STAGE(PG8_SA(0, 1), a2 + hstep, voffA);
            PG8_WAIT_V(8); PG8_WAIT_L(0); PG8_BAR; PG8_MMA(0, 0, At, B0); PG8_MMA(0, 1, At, B1); PG8_BAR; PG8_SCHED;
            PG8_LDA(At, 1, 1); PG8_STAGE(PG8_SB(1, 0), b3, voffB); PG8_STAGE(PG8_SB(1, 1), b3 + hstep, voffB); PG8_STAGE(PG8_SA(1, 0), a3, voffA);
            PG8_WAIT_V(8); PG8_WAIT_L(0); PG8_BAR; PG8_MMA(1, 0, At, B0); PG8_MMA(1, 1, At, B1); PG8_BAR; PG8_SCHED;
            } else {
            PG8_LDB(B0, 0, 0); PG8_SCHED; PG8_LDA(At, 0, 0); PG8_STAGE(PG8_SA(1, 1), a1 + hstep, voffA);
            PG8_WAIT_L(8); PG8_BAR; PG8_WAIT_L(0); PG8_MMA(0, 0, At, B0); PG8_BAR; PG8_SCHED;
            PG8_LDB(B1, 0, 1); PG8_STAGE(PG8_SB(0, 0), b2, voffB);
            PG8_BAR; PG8_WAIT_L(0); PG8_MMA(0, 1, At, B1); PG8_BAR;
            PG8_LDA(At, 0, 1); PG8_STAGE(PG8_SA(0, 0), a2, voffA);
            PG8_BAR; PG8_WAIT_L(0); PG8_MMA(1, 0, At, B0); PG8_BAR; PG8_SCHED;
            PG8_STAGE(PG8_SB(0, 1), b2 + hstep, voffB);
            PG8_WAIT_V(6); PG8_BAR; PG8_MMA(1, 1, At, B1); PG8_BAR;
            PG8_LDB(B0, 1, 0); PG8_SCHED; PG8_LDA(At, 1, 0); PG8_STAGE(PG8_SA(0, 1), a2 + hstep, voffA);
            PG8_WAIT_L(8); PG8_BAR; PG8_WAIT_L(0); PG8_MMA(0, 0, At, B0); PG8_BAR; PG8_SCHED;
            PG8_LDB(B1, 1, 1); PG8_STAGE(PG8_SB(1, 0), b3, voffB);
            PG8_BAR; PG8_WAIT_L(0); PG8_MMA(0, 1, At, B1); PG8_BAR;
            PG8_LDA(At, 1, 1); PG8_STAGE(PG8_SA(1, 0), a3, voffA);
            PG8_BAR; PG8_WAIT_L(0); PG8_MMA(1, 0, At, B0); PG8_BAR; PG8_SCHED;
            PG8_STAGE(PG8_SB(1, 1), b3 + hstep, voffB);
            PG8_WAIT_V(6); PG8_BAR; PG8_MMA(1, 1, At, B1); PG8_BAR;
            }
        }
        if constexpr (ALIGN_EPI) { if (wr == 0) PG8_BAR; }
        if constexpr (!Epi::AFTER_DRAIN) { E(acc, cur, wr, wc, fr, fq); S.done(cur); }
        if (!has_next) break;
#pragma unroll
        for (int a = 0; a < 2; ++a)
#pragma unroll
            for (int b = 0; b < 2; ++b)
#pragma unroll
                for (int m = 0; m < 4; ++m)
#pragma unroll
                    for (int n = 0; n < 2; ++n) acc[a][b][m][n] = (f32x4){0.f, 0.f, 0.f, 0.f};
        cur = nxt; cA = nA; cB = nB; ++ui;
        if constexpr (ALIGN_EPI) { if (wr == 1) PG8_BAR; }
    }
    PG8_WAIT_V(0);
    if constexpr (!ALIGN_EPI) { if (wr == 0) PG8_BAR; }
    PG8_BAR;
    if constexpr (Epi::AFTER_DRAIN) { E.fused(acc, cur, wr, wc, fr, fq, lds, wid, lane); S.done(cur); }
#undef PG8_SA
#undef PG8_SB
#undef PG8_STAGE
#undef PG8_LDA
#undef PG8_LDB
#undef PG8_MMA
#undef PG8_WAIT_V
#undef PG8_WAIT_L
#undef PG8_BAR
#undef PG8_SCHED
}
}

#define LAS __attribute__((address_space(3)))
typedef unsigned short bf16;
typedef short bf16x8 __attribute__((ext_vector_type(8)));
typedef float f32x4 __attribute__((ext_vector_type(4)));
typedef float f32x2 __attribute__((ext_vector_type(2)));
typedef unsigned u32x4 __attribute__((ext_vector_type(4)));
typedef unsigned u32x2 __attribute__((ext_vector_type(2)));

constexpr int M = 32768, D = 1024, SEQ = 16384, DFF = 2816;
constexpr float LN_EPS = 1e-5f;
constexpr float ALPHA = 1.681792830507429f;
constexpr int NWAVES = 8;
constexpr int LDS_BYTES = 147456;
constexpr size_t HMiB = 524288;
constexpr size_t WS_WIN0 = 0, WS_WIN1 = 9 * HMiB, WS_WIN2 = 15 * HMiB, WS_WIN3 = 24 * HMiB;
constexpr size_t WS_WO = 38 * HMiB;
constexpr size_t WS_WF1 = 58 * HMiB;
constexpr size_t WS_WF2 = 146 * HMiB;
constexpr size_t WS_WKV = 190 * HMiB;
constexpr size_t WS_WSM = 198 * HMiB;
constexpr size_t WS_MEMB = 200 * HMiB;
constexpr size_t WS_KVM = 202 * HMiB;
constexpr size_t WS_XB = 208 * HMiB;
constexpr size_t WS_HB = 336 * HMiB;
constexpr size_t WS_BR = 688 * HMiB;
constexpr size_t WS_BAR = 848 * HMiB;
constexpr size_t WS_END = 849 * HMiB;
constexpr int MISC_OFF = LDS_BYTES - 64;

__constant__ unsigned char T5B[256] = {
15,15,15,15,15,15,15,15,15,15,15,15,15,15,15,15,15,15,15,15,15,15,15,15,15,15,15,15,15,15,15,15,15,15,15,15,15,15,15,15,15,15,15,15,15,15,15,15,15,15,15,15,15,15,15,15,15,15,15,15,15,15,15,15,15,15,15,15,15,15,15,15,15,15,15,15,15,15,15,15,15,15,15,15,15,15,15,15,15,15,15,15,15,15,15,15,15,15,15,15,15,14,14,14,14,14,14,14,14,14,14,14,14,14,14,14,14,14,14,14,14,14,14,14,14,14,14,14,13,13,13,13,13,13,13,13,13,13,13,13,13,13,13,13,13,13,12,12,12,12,12,12,12,12,12,12,12,12,12,12,11,11,11,11,11,11,11,11,11,10,10,10,10,10,10,10,9,9,9,9,8,8,8,8,7,6,5,4,3,2,1,0,17,18,19,20,21,22,23,24,24,24,24,25,25,25,25,26,26,26,26,26,26,26,27,27,27,27,27,27,27,27,27,28,28,28,28,28,28,28,28,28,28,28,28,28,28,29,29,29,29,29,29,29,29,29,29,29,29,29,29,29,29,29,29,0};

__device__ __forceinline__ float bflo(unsigned u) { return __uint_as_float(u << 16); }
__device__ __forceinline__ float bfhi(unsigned u) { return __uint_as_float(u & 0xffff0000u); }
__device__ __forceinline__ unsigned pk2(float lo, float hi) { return pg8::cvt_pk_bf16(lo, hi); }
__device__ __forceinline__ float fexp(float x) { return __builtin_amdgcn_exp2f(x * 1.4426950408889634f); }
__device__ __forceinline__ float frcp(float x) { return __builtin_amdgcn_rcpf(x); }
__device__ __forceinline__ float fsigm(float x) { return frcp(1.f + fexp(-x)); }
__device__ __forceinline__ float wave_sum(float v) {
#pragma unroll
    for (int o = 1; o < 64; o <<= 1) v += __shfl_xor(v, o);
    return v;
}
__device__ __forceinline__ float act1(int mode, float a, float b) {
    if (mode == 1) { const float t = 1.5957691216057308f * (a + 0.044715f * a * a * a); return a * fsigm(t); }
    if (mode == 2) return a * fsigm(b);
    if (mode == 3) return a * b;
    return a * fsigm(a) * b;
}

struct EpiAct {
    static constexpr bool PERM = true, AFTER_DRAIN = false;
    bf16* O; int ldc; int t1, t2, m0, m1, m2, c0, c1, c2;
    __device__ __forceinline__ void operator()(const f32x4 (&acc)[2][2][4][2], const pg8::Unit& u, int wr, int wc, int fr, int fq) const {
        const int pn = u.pn; int mode, dcol;
        if (pn < t1) { mode = m0; dcol = c0 + (m0 >= 2 ? 128 : 256) * pn; }
        else if (pn < t2) { mode = m1; dcol = c1 + (m1 >= 2 ? 128 : 256) * (pn - t1); }
        else { mode = m2; dcol = c2 + (m2 >= 2 ? 128 : 256) * (pn - t2); }
        const int row0 = u.pm * 256 + wr * 64 + fr, col0 = dcol + wc * 32 + 8 * fq;
        if (mode < 2) {
#pragma unroll
            for (int ai = 0; ai < 2; ++ai)
#pragma unroll
                for (int m = 0; m < 4; ++m) { bf16* rowp = O + (size_t)(row0 + ai * 128 + m * 16) * ldc + col0;
#pragma unroll
                    for (int bj = 0; bj < 2; ++bj) { f32x4 v0 = acc[ai][bj][m][0], v1 = acc[ai][bj][m][1];
                        if (mode == 1) {
#pragma unroll
                            for (int e = 0; e < 4; ++e) { v0[e] = act1(1, v0[e], 0.f); v1[e] = act1(1, v1[e], 0.f); } }
                        u32x4 w; w.x = pk2(v0[0], v0[1]); w.y = pk2(v0[2], v0[3]); w.z = pk2(v1[0], v1[1]); w.w = pk2(v1[2], v1[3]);
                        *(u32x4*)(rowp + bj * 128) = w; }
                    asm volatile("" ::: "memory"); }
        } else {
#pragma unroll
            for (int ai = 0; ai < 2; ++ai)
#pragma unroll
                for (int m = 0; m < 4; ++m) { bf16* rowp = O + (size_t)(row0 + ai * 128 + m * 16) * ldc + col0;
                    f32x4 v0, v1;
#pragma unroll
                    for (int e = 0; e < 4; ++e) { v0[e] = act1(mode, acc[ai][0][m][0][e], acc[ai][1][m][0][e]); v1[e] = act1(mode, acc[ai][0][m][1][e], acc[ai][1][m][1][e]); }
                    u32x4 w; w.x = pk2(v0[0], v0[1]); w.y = pk2(v0[2], v0[3]); w.z = pk2(v1[0], v1[1]); w.w = pk2(v1[2], v1[3]);
                    *(u32x4*)rowp = w; asm volatile("" ::: "memory"); }
        }
    }
};
struct EpiRes {
    static constexpr bool PERM = false, AFTER_DRAIN = false;
    const float* R; float* Y; float alpha;
    __device__ __forceinline__ void operator()(const f32x4 (&acc)[2][2][4][2], const pg8::Unit& u, int wr, int wc, int fr, int fq) const {
        const int col0 = u.pn * 256 + wc * 32 + 4 * fq;
#pragma unroll
        for (int ai = 0; ai < 2; ++ai)
#pragma unroll
            for (int m = 0; m < 4; ++m) { const size_t off = (size_t)(u.pm * 256 + ai * 128 + wr * 64 + m * 16 + fr) * D + col0;
#pragma unroll
                for (int bj = 0; bj < 2; ++bj)
#pragma unroll
                    for (int n = 0; n < 2; ++n) { const f32x4 rv = *(const f32x4*)(R + off + bj * 128 + n * 16); *(f32x4*)(Y + off + bj * 128 + n * 16) = rv * alpha + acc[ai][bj][m][n]; }
                asm volatile("" ::: "memory"); }
    }
};

struct Args { const float* in[25]; float* out; unsigned char* ws; };
#define LAUNDER_TID() int tid = threadIdx.x; asm volatile("" : "+v"(tid)); const int lane = tid & 63, wave = __builtin_amdgcn_readfirstlane(tid >> 6); (void)lane; (void)wave

__device__ __forceinline__ void transpose_item(const float* W, int K, int N, bf16* WT, int r0, int r1, int half, LAS float* scr, int item, int lane) {
    const int nblk = N / 32, kb = item / nblk, nb = item % nblk, k0 = 64 * kb, n0 = 32 * nb;
    int s0 = n0; if (n0 >= r0 && n0 < r1) { const int rp = n0 - r0; s0 = r0 + ((rp >> 7) & 1) * half + 128 * (rp >> 8) + (rp & 127); }
#pragma unroll 8
    for (int i = 0; i < 32; ++i) { const int kk = 2 * i + (lane >> 5); scr[kk * 33 + (lane & 31)] = W[(size_t)(k0 + kk) * N + s0 + (lane & 31)]; }
    asm volatile("s_waitcnt lgkmcnt(0)" ::: "memory");
    const int c = lane & 7;
#pragma unroll
    for (int j = 0; j < 4; ++j) { const int n = (lane >> 3) + 8 * j; const LAS float* s = scr + (8 * c) * 33 + n;
        u32x4 o; o.x = pk2(s[0 * 33], s[1 * 33]); o.y = pk2(s[2 * 33], s[3 * 33]); o.z = pk2(s[4 * 33], s[5 * 33]); o.w = pk2(s[6 * 33], s[7 * 33]);
        *(u32x4*)(WT + (size_t)(n0 + n) * K + k0 + 8 * c) = o; }
    asm volatile("s_waitcnt lgkmcnt(0)" ::: "memory");
}
__device__ __forceinline__ void transpose_weight(const float* W, int K, int N, bf16* WT, int r0, int r1, int half, LAS float* scr, int gw, int NGW, int& rot, int lane) {
    const int items = (K / 64) * (N / 32);
    for (int it = (gw + NGW - rot) % NGW; it < items; it += NGW) transpose_item(W, K, N, WT, r0, r1, half, scr, it, lane);
    rot = (rot + items) % NGW;
}
__device__ __forceinline__ void cvt_rows_bf16(const float* src, bf16* dst, size_t n8, size_t gt, size_t GT) {
    for (size_t i = gt; i < n8; i += GT) { const f32x4 a = ((const f32x4*)src)[2 * i], b = ((const f32x4*)src)[2 * i + 1];
        u32x4 o; o.x = pk2(a[0], a[1]); o.y = pk2(a[2], a[3]); o.z = pk2(b[0], b[1]); o.w = pk2(b[2], b[3]); ((u32x4*)dst)[i] = o; }
}
__device__ __forceinline__ void prologue(const Args& a, LAS unsigned char* lds) {
    LAUNDER_TID();
    unsigned char* ws = a.ws; const int G = gridDim.x;
    LAS float* scr = (LAS float*)(lds + wave * 16384);
    const int gw = blockIdx.x * NWAVES + wave, NGW = G * NWAVES; int rot = 0;
    const size_t win_off[4] = {WS_WIN0, WS_WIN1, WS_WIN2, WS_WIN3};
#pragma unroll
    for (int l = 0; l < 4; ++l) {
        const int winN = l == 0 ? 2304 : l == 1 ? 1536 : l == 2 ? 2304 : 3328;
        const float* win = l == 0 ? a.in[2] : l == 1 ? a.in[7] : l == 2 ? a.in[10] : a.in[15];
        const int r0 = l == 3 ? 1024 : 0, r1 = l == 2 ? 2048 : l == 3 ? 3072 : 0;
        transpose_weight(win, 1024, winN, (bf16*)(ws + win_off[l]), r0, r1, 1024, scr, gw, NGW, rot, lane);
        transpose_weight(a.in[18] + (size_t)l * 1280 * 1024, 1280, 1024, (bf16*)(ws + WS_WO) + (size_t)l * 1280 * 1024, 0, 0, 0, scr, gw, NGW, rot, lane);
        transpose_weight(a.in[21] + (size_t)l * 1024 * 5632, 1024, 5632, (bf16*)(ws + WS_WF1) + (size_t)l * 1024 * 5632, 0, 5632, 2816, scr, gw, NGW, rot, lane);
        transpose_weight(a.in[22] + (size_t)l * 2816 * 1024, 2816, 1024, (bf16*)(ws + WS_WF2) + (size_t)l * 2816 * 1024, 0, 0, 0, scr, gw, NGW, rot, lane);
        transpose_weight(a.in[17] + (size_t)l * 1024 * 512, 1024, 512, (bf16*)(ws + WS_WKV) + (size_t)l * 1024 * 512, 0, 0, 0, scr, gw, NGW, rot, lane);
    }
    const size_t gt = (size_t)blockIdx.x * 512 + tid, GT = (size_t)G * 512;
    cvt_rows_bf16(a.in[0], (bf16*)(ws + WS_XB), (size_t)M * D / 8, gt, GT);
    cvt_rows_bf16(a.in[1], (bf16*)(ws + WS_MEMB), (size_t)512 * 1024 / 8, gt, GT);
    { const float* wsrc = a.in[5]; bf16* wd = (bf16*)(ws + WS_WSM);
      for (size_t i = gt; i < 8 * 128 * 128; i += GT) { const int jj = (int)(i & 127), ii = (int)((i >> 7) & 127); const float v = ((jj >> 6) <= (ii >> 6)) ? wsrc[i] : 0.f; wd[i] = (bf16)(pk2(v, 0.f) & 0xffffu); } }
}

__device__ __forceinline__ void ln_phase(float* Y, bf16* XB, const float* gam, const float* bet) {
    LAUNDER_TID();
    const int gw = blockIdx.x * NWAVES + wave, NGW = gridDim.x * NWAVES;
    f32x4 g4[4], b4[4];
#pragma unroll
    for (int j = 0; j < 4; ++j) { g4[j] = ((const f32x4*)gam)[lane + 64 * j]; b4[j] = ((const f32x4*)bet)[lane + 64 * j]; }
    for (int m = gw; m < M; m += NGW) {
        f32x4* xr = (f32x4*)(Y + (size_t)m * D) + lane;
        f32x4 v[4]; float s = 0.f;
#pragma unroll
        for (int j = 0; j < 4; ++j) { v[j] = xr[64 * j]; s += (v[j][0] + v[j][1]) + (v[j][2] + v[j][3]); }
        const float mean = wave_sum(s) * (1.f / D); float s2 = 0.f;
#pragma unroll
        for (int j = 0; j < 4; ++j) { v[j] = v[j] - mean; s2 += (v[j][0] * v[j][0] + v[j][1] * v[j][1]) + (v[j][2] * v[j][2] + v[j][3] * v[j][3]); }
        const float rstd = 1.f / sqrtf(wave_sum(s2) * (1.f / D) + LN_EPS);
        u32x2* o8 = (u32x2*)(XB + (size_t)m * D) + lane;
#pragma unroll
        for (int j = 0; j < 4; ++j) { const f32x4 o = v[j] * rstd * g4[j] + b4[j]; xr[64 * j] = o; u32x2 w; w.x = pk2(o[0], o[1]); w.y = pk2(o[2], o[3]); o8[64 * j] = w; }
    }
}

template <int NKT, bool SWA>
__device__ __forceinline__ void attn_tile16(const bf16* q, int ldq, const LAS bf16* KL, const LAS bf16* VT, int vts, const LAS float* btab, int qc0, float sink, int kt_first, bf16* o, int ldo, int lane) {
    const int fr = lane & 15, fq = lane >> 4;
    const bf16x8 qf0 = *(const bf16x8*)(q + (size_t)fr * ldq + 8 * fq), qf1 = *(const bf16x8*)(q + (size_t)fr * ldq + 32 + 8 * fq);
    f32x4 s[NKT];
#pragma unroll
    for (int kt = 0; kt < NKT; ++kt) {
        const LAS bf16* kp = KL + (16 * kt + fr) * 72 + 8 * fq;
        const bf16x8 k0 = *(const LAS bf16x8*)kp, k1 = *(const LAS bf16x8*)(kp + 32);
        f32x4 z = {0.f, 0.f, 0.f, 0.f};
        z = __builtin_amdgcn_mfma_f32_16x16x32_bf16(k0, qf0, z, 0, 0, 0);
        s[kt] = __builtin_amdgcn_mfma_f32_16x16x32_bf16(k1, qf1, z, 0, 0, 0);
    }
    float mx = SWA ? sink : -3.0e38f;
#pragma unroll
    for (int kt = 0; kt < NKT; ++kt) {
        if (!SWA || kt >= kt_first) {
#pragma unroll
            for (int e = 0; e < 4; ++e) { float v = s[kt][e] * 0.125f; if (SWA) v += btab[16 * kt + 4 * fq + e - (qc0 + fr) + 63]; s[kt][e] = v; mx = fmaxf(mx, v); }
        }
    }
    mx = fmaxf(mx, __shfl_xor(mx, 16)); mx = fmaxf(mx, __shfl_xor(mx, 32));
    float sum = 0.f;
#pragma unroll
    for (int kt = 0; kt < NKT; ++kt) {
        if (!SWA || kt >= kt_first) {
#pragma unroll
            for (int e = 0; e < 4; ++e) { const float p = fexp(s[kt][e] - mx); s[kt][e] = p; sum += p; }
        } else s[kt] = (f32x4){0.f, 0.f, 0.f, 0.f};
    }
    sum += __shfl_xor(sum, 16); sum += __shfl_xor(sum, 32);
    if (SWA) sum += fexp(sink - mx);
    const float inv = 1.f / sum;
    f32x4 oa[4];
#pragma unroll
    for (int dt = 0; dt < 4; ++dt) oa[dt] = (f32x4){0.f, 0.f, 0.f, 0.f};
#pragma unroll
    for (int t = 0; t < NKT / 2; ++t) {
        u32x4 pw; pw.x = pk2(s[2 * t][0], s[2 * t][1]); pw.y = pk2(s[2 * t][2], s[2 * t][3]); pw.z = pk2(s[2 * t + 1][0], s[2 * t + 1][1]); pw.w = pk2(s[2 * t + 1][2], s[2 * t + 1][3]);
        const bf16x8 pf = __builtin_bit_cast(bf16x8, pw);
#pragma unroll
        for (int dt = 0; dt < 4; ++dt) {
            const LAS bf16* vp = VT + (16 * dt + fr) * vts + 32 * t + 4 * fq;
            const u32x2 lo = *(const LAS u32x2*)vp, hi = *(const LAS u32x2*)(vp + 16);
            u32x4 vw; vw.x = lo.x; vw.y = lo.y; vw.z = hi.x; vw.w = hi.y;
            oa[dt] = __builtin_amdgcn_mfma_f32_16x16x32_bf16(__builtin_bit_cast(bf16x8, vw), pf, oa[dt], 0, 0, 0);
        }
    }
#pragma unroll
    for (int dt = 0; dt < 4; ++dt) { u32x2 w; w.x = pk2(oa[dt][0] * inv, oa[dt][1] * inv); w.y = pk2(oa[dt][2] * inv, oa[dt][3] * inv); *(u32x2*)(o + (size_t)fr * ldo + 16 * dt + 4 * fq) = w; }
}

__device__ __forceinline__ void swa_phase(const Args& a, LAS unsigned char* lds) {
    LAUNDER_TID();
    const bf16* H = (const bf16*)(a.ws + WS_HB); bf16* BR = (bf16*)(a.ws + WS_BR);
    LAS bf16* KL = (LAS bf16*)lds; LAS bf16* VT = (LAS bf16*)(lds + 27648); LAS unsigned* VTd = (LAS unsigned*)(lds + 27648); LAS float* BT = (LAS float*)(lds + 53248);
    const float* sinks = a.in[8]; const float* relb = a.in[9];
    for (int unit = blockIdx.x; unit < 1024; unit += gridDim.x) {
        const int kvh = unit & 1, n = (unit >> 1) & 255, b = unit >> 9;
        const int rowq0 = b * SEQ + 64 * n, rowk0 = rowq0 - 128, kt_first = n >= 2 ? 0 : (n == 1 ? 4 : 8);
#pragma unroll
        for (int i = 0; i < 3; ++i) { const int q = tid + 512 * i, row = q >> 3, ch = q & 7; u32x4 v = {0u, 0u, 0u, 0u};
            if (row >= 16 * kt_first) v = *(const u32x4*)(H + (size_t)(rowk0 + row) * 1536 + 1024 + kvh * 64 + 8 * ch);
            *(LAS u32x4*)(KL + row * 72 + 8 * ch) = v; }
        for (int q = tid; q < 768; q += 512) { const int ch = q & 7, kp = q >> 3; u32x4 v0 = {0u, 0u, 0u, 0u}, v1 = {0u, 0u, 0u, 0u};
            if (2 * kp >= 16 * kt_first) { const bf16* p = H + (size_t)(rowk0 + 2 * kp) * 1536 + 1152 + kvh * 64 + 8 * ch; v0 = *(const u32x4*)p; v1 = *(const u32x4*)(p + 1536); }
#pragma unroll
            for (int e = 0; e < 4; ++e) { const unsigned x0 = v0[e], x1 = v1[e];
                VTd[(8 * ch + 2 * e) * 100 + kp] = (x0 & 0xffffu) | (x1 << 16);
                VTd[(8 * ch + 2 * e + 1) * 100 + kp] = (x0 >> 16) | (x1 & 0xffff0000u); } }
#pragma unroll
        for (int i = 0; i < 4; ++i) { const int q = tid + 512 * i, g = q >> 8, idx = q & 255; BT[q] = relb[(int)T5B[idx] * 16 + kvh * 8 + g]; }
        __syncthreads();
        const int h = kvh * 8 + wave; const float sink = sinks[h];
        for (int rt = 0; rt < 4; ++rt)
            attn_tile16<12, true>(H + (size_t)(rowq0 + 16 * rt) * 1536 + h * 64, 1536, KL, VT, 200, BT + wave * 256, 16 * rt, sink, kt_first, BR + (size_t)(rowq0 + 16 * rt) * 1280 + h * 64, 1280, lane);
        __syncthreads();
    }
}

__device__ __forceinline__ void xattn_phase(const Args& a, int layer, int ldh, int qxoff, LAS unsigned char* lds) {
    LAUNDER_TID();
    const bf16* H = (const bf16*)(a.ws + WS_HB); bf16* BR = (bf16*)(a.ws + WS_BR); const bf16* KVM = (const bf16*)(a.ws + WS_KVM) + (size_t)layer * 512 * 512;
    LAS bf16* KL = (LAS bf16*)lds; LAS bf16* VT = (LAS bf16*)(lds + 36864); LAS unsigned* VTd = (LAS unsigned*)(lds + 36864);
    for (int unit = blockIdx.x; unit < 256; unit += gridDim.x) {
        const int xh = unit & 3, rb = (unit >> 2) & 31, b = unit >> 7;
        const int rows0 = b * SEQ + 512 * rb;
#pragma unroll
        for (int i = 0; i < 4; ++i) { const int q = tid + 512 * i, row = q >> 3, ch = q & 7;
            *(LAS u32x4*)(KL + row * 72 + 8 * ch) = *(const u32x4*)(KVM + (size_t)(b * 256 + row) * 512 + xh * 64 + 8 * ch); }
#pragma unroll
        for (int i = 0; i < 2; ++i) { const int q = tid + 512 * i, ch = q & 7, kp = q >> 3;
            const bf16* p = KVM + (size_t)(b * 256 + 2 * kp) * 512 + 256 + xh * 64 + 8 * ch; const u32x4 v0 = *(const u32x4*)p, v1 = *(const u32x4*)(p + 512);
#pragma unroll
            for (int e = 0; e < 4; ++e) { const unsigned x0 = v0[e], x1 = v1[e];
                VTd[(8 * ch + 2 * e) * 164 + kp] = (x0 & 0xffffu) | (x1 << 16);
                VTd[(8 * ch + 2 * e + 1) * 164 + kp] = (x0 >> 16) | (x1 & 0xffff0000u); } }
        __syncthreads();
        for (int rt = wave; rt < 32; rt += 8)
            attn_tile16<16, false>(H + (size_t)(rows0 + 16 * rt) * ldh + qxoff + xh * 64, ldh, KL, VT, 328, nullptr, 0, 0.f, 0, BR + (size_t)(rows0 + 16 * rt) * 1280 + 1024 + xh * 64, 1280, lane);
        __syncthreads();
    }
}

__device__ __forceinline__ void sgu_phase(const Args& a, LAS unsigned char* lds) {
    LAUNDER_TID();
    const bf16* H = (const bf16*)(a.ws + WS_HB); bf16* BR = (bf16*)(a.ws + WS_BR); const bf16* WSM = (const bf16*)(a.ws + WS_WSM);
    LAS float* stat = (LAS float*)lds; LAS unsigned* VTd = (LAS unsigned*)(lds + 1024); LAS bf16* WL = (LAS bf16*)(lds + 1024 + 34816);
    const float* gam = a.in[3]; const float* bet = a.in[4]; const float* bs = a.in[6];
    const int fr = lane & 15, fq = lane >> 4;
    for (int nb = blockIdx.x; nb < 256; nb += gridDim.x) {
        const int r0 = 128 * nb;
        for (int rr = 0; rr < 16; ++rr) { const int row = 16 * wave + rr; const u32x4* p = (const u32x4*)(H + (size_t)(r0 + row) * 2304 + 1024);
            const u32x4 v0 = p[lane], v1 = p[lane + 64]; float x[16];
#pragma unroll
            for (int e = 0; e < 4; ++e) { x[2 * e] = bflo(v0[e]); x[2 * e + 1] = bfhi(v0[e]); x[8 + 2 * e] = bflo(v1[e]); x[9 + 2 * e] = bfhi(v1[e]); }
            float s = 0.f;
#pragma unroll
            for (int e = 0; e < 16; ++e) s += x[e];
            const float mean = wave_sum(s) * (1.f / 1024.f); float s2 = 0.f;
#pragma unroll
            for (int e = 0; e < 16; ++e) { const float d = x[e] - mean; s2 += d * d; }
            const float rstd = 1.f / sqrtf(wave_sum(s2) * (1.f / 1024.f) + LN_EPS);
            if (lane == 0) { stat[2 * row] = mean; stat[2 * row + 1] = rstd; } }
        __syncthreads();
        for (int g = 0; g < 8; ++g) {
#pragma unroll
            for (int i2 = 0; i2 < 2; ++i2) { const int q = tid + 512 * i2, cc = q & 15, jp = q >> 4, j0 = 2 * jp;
                const bf16* p = H + (size_t)(r0 + j0) * 2304 + 1024 + 128 * g + 8 * cc; const u32x4 A0 = *(const u32x4*)p, A1 = *(const u32x4*)(p + 2304);
                const float m0 = stat[2 * j0], rs0 = stat[2 * j0 + 1], m1 = stat[2 * j0 + 2], rs1 = stat[2 * j0 + 3];
                const f32x4 ga0 = *(const f32x4*)(gam + 128 * g + 8 * cc), ga1 = *(const f32x4*)(gam + 128 * g + 8 * cc + 4), be0 = *(const f32x4*)(bet + 128 * g + 8 * cc), be1 = *(const f32x4*)(bet + 128 * g + 8 * cc + 4);
#pragma unroll
                for (int e = 0; e < 4; ++e) { const float gl = e < 2 ? ga0[2 * e] : ga1[2 * e - 4], gh = e < 2 ? ga0[2 * e + 1] : ga1[2 * e - 3], bl = e < 2 ? be0[2 * e] : be1[2 * e - 4], bh = e < 2 ? be0[2 * e + 1] : be1[2 * e - 3];
                    const float y0l = (bflo(A0[e]) - m0) * rs0 * gl + bl, y1l = (bflo(A1[e]) - m1) * rs1 * gl + bl, y0h = (bfhi(A0[e]) - m0) * rs0 * gh + bh, y1h = (bfhi(A1[e]) - m1) * rs1 * gh + bh;
                    VTd[(8 * cc + 2 * e) * 68 + (jp ^ (4 * cc))] = pk2(y0l, y1l);
                    VTd[(8 * cc + 2 * e + 1) * 68 + (jp ^ (4 * cc))] = pk2(y0h, y1h); } }
#pragma unroll
            for (int i4 = 0; i4 < 4; ++i4) { const int q = tid + 512 * i4, row = q >> 4, ch = q & 15;
                *(LAS u32x4*)(WL + row * 136 + 8 * ch) = *(const u32x4*)(WSM + (size_t)(g * 128 + row) * 128 + 8 * ch); }
            __syncthreads();
            const int c = 16 * wave + fr; bf16x8 af[4];
#pragma unroll
            for (int kk = 0; kk < 4; ++kk) af[kk] = *(const LAS bf16x8*)(VTd + c * 68 + ((16 * kk + 4 * fq) ^ (4 * ((c >> 3) & 15))));
#pragma unroll
            for (int it = 0; it < 8; ++it) { f32x4 acc = {0.f, 0.f, 0.f, 0.f};
#pragma unroll
                for (int kk = 0; kk < 4; ++kk) if (it >= 4 || kk < 2) { const bf16x8 bfr = *(const LAS bf16x8*)(WL + (16 * it + fr) * 136 + 32 * kk + 8 * fq); acc = __builtin_amdgcn_mfma_f32_16x16x32_bf16(af[kk], bfr, acc, 0, 0, 0); }
                const int i = 16 * it + fr, col = 128 * g + 16 * wave + 4 * fq; const float bias = bs[g * 128 + i];
                const u32x2 uu = *(const u32x2*)(H + (size_t)(r0 + i) * 2304 + col);
                u32x2 w; w.x = pk2(bflo(uu.x) * (acc[0] + bias), bfhi(uu.x) * (acc[1] + bias)); w.y = pk2(bflo(uu.y) * (acc[2] + bias), bfhi(uu.y) * (acc[3] + bias));
                *(u32x2*)(BR + (size_t)(r0 + i) * 1280 + col) = w; }
            __syncthreads();
        }
    }
}

__device__ __forceinline__ void conv31_phase(const Args& a, LAS unsigned char* lds) {
    LAUNDER_TID();
    const bf16* H = (const bf16*)(a.ws + WS_HB); bf16* BR = (bf16*)(a.ws + WS_BR);
    const float* cw = a.in[11]; const float* cb = a.in[12]; const float* lg = a.in[13]; const float* lb = a.in[14];
    LAS float* red = (LAS float*)lds; LAS float* tot = (LAS float*)(lds + 65536);
    const int c0 = 2 * tid;
    const f32x2 cbv = *(const f32x2*)(cb + c0), lgv = *(const f32x2*)(lg + c0), lbv = *(const f32x2*)(lb + c0);
    for (int strip = blockIdx.x; strip < M / 16; strip += gridDim.x) {
        const int R0 = 16 * strip, tseq = R0 & (SEQ - 1);
        float xl[46], xh[46];
#pragma unroll
        for (int i = 0; i < 46; ++i) { unsigned pk = 0u; if (tseq - 30 + i >= 0) pk = ((const unsigned*)(H + (size_t)(R0 - 30 + i) * 1280))[tid]; xl[i] = bflo(pk); xh[i] = bfhi(pk); }
        float al[16], ah[16];
#pragma unroll
        for (int o = 0; o < 16; ++o) { al[o] = cbv.x; ah[o] = cbv.y; }
#pragma unroll
        for (int k = 0; k < 31; ++k) { const f32x2 wk = *(const f32x2*)(cw + k * 1024 + c0);
#pragma unroll
            for (int o = 0; o < 16; ++o) { al[o] += wk.x * xl[o + k]; ah[o] += wk.y * xh[o + k]; } }
#pragma unroll
        for (int o = 0; o < 16; ++o) { red[o * 512 + tid] = al[o] + ah[o]; red[(16 + o) * 512 + tid] = al[o] * al[o] + ah[o] * ah[o]; }
        __syncthreads();
        { const int v = tid >> 4, l = tid & 15; float s = 0.f;
#pragma unroll
          for (int i = 0; i < 32; ++i) s += red[v * 512 + i * 16 + l];
          s += __shfl_xor(s, 1); s += __shfl_xor(s, 2); s += __shfl_xor(s, 4); s += __shfl_xor(s, 8);
          if (l == 0) tot[v] = s; }
        __syncthreads();
#pragma unroll
        for (int o = 0; o < 16; ++o) { const float mean = tot[o] * (1.f / 1024.f), var = tot[16 + o] * (1.f / 1024.f) - mean * mean, rstd = 1.f / sqrtf(fmaxf(var, 0.f) + LN_EPS);
            const float yl = (al[o] - mean) * rstd * lgv.x + lbv.x, yh = (ah[o] - mean) * rstd * lgv.y + lbv.y;
            ((unsigned*)(BR + (size_t)(R0 + o) * 1280))[tid] = pk2(yl * fsigm(yl), yh * fsigm(yh)); }
        __syncthreads();
    }
}

__device__ __forceinline__ void conv3_phase(const Args& a) {
    LAUNDER_TID();
    const bf16* H = (const bf16*)(a.ws + WS_HB); bf16* BR = (bf16*)(a.ws + WS_BR); const float* w = a.in[16];
    const size_t gt = (size_t)blockIdx.x * 512 + tid, GT = (size_t)gridDim.x * 512;
    for (size_t it = gt; it < (size_t)M * 128; it += GT) { const int row = (int)(it >> 7), ch = (int)(it & 127), tseq = row & (SEQ - 1);
        const bf16* hp = H + (size_t)row * 2304 + 8 * ch;
        const u32x4 bg = *(const u32x4*)hp, p2 = *(const u32x4*)(hp + 1024);
        u32x4 p1 = {0u, 0u, 0u, 0u}, p0 = {0u, 0u, 0u, 0u};
        if (tseq >= 1) p1 = *(const u32x4*)(hp + 1024 - 2304);
        if (tseq >= 2) p0 = *(const u32x4*)(hp + 1024 - 4608);
        const f32x4 w0a = *(const f32x4*)(w + 8 * ch), w0b = *(const f32x4*)(w + 8 * ch + 4), w1a = *(const f32x4*)(w + 1024 + 8 * ch), w1b = *(const f32x4*)(w + 1024 + 8 * ch + 4), w2a = *(const f32x4*)(w + 2048 + 8 * ch), w2b = *(const f32x4*)(w + 2048 + 8 * ch + 4);
        u32x4 o;
#pragma unroll
        for (int e = 0; e < 4; ++e) { const float k0l = e < 2 ? w0a[2 * e] : w0b[2 * e - 4], k0h = e < 2 ? w0a[2 * e + 1] : w0b[2 * e - 3], k1l = e < 2 ? w1a[2 * e] : w1b[2 * e - 4], k1h = e < 2 ? w1a[2 * e + 1] : w1b[2 * e - 3], k2l = e < 2 ? w2a[2 * e] : w2b[2 * e - 4], k2h = e < 2 ? w2a[2 * e + 1] : w2b[2 * e - 3];
            const float yl = bflo(bg[e]) * (k0l * bflo(p0[e]) + k1l * bflo(p1[e]) + k2l * bflo(p2[e])), yh = bfhi(bg[e]) * (k0h * bfhi(p0[e]) + k1h * bfhi(p1[e]) + k2h * bfhi(p2[e]));
            o[e] = pk2(yl, yh); }
        *(u32x4*)(BR + (size_t)row * 1280 + 8 * ch) = o; }
}

#define XB_TMO      128
#define XB_XCNT(j)  (256  + 64 * (j))
#define XB_XSUB(j)  (1280 + 64 * (j))
#define XB_XGEN(j)  (2304 + 64 * (j))
#define XB_TOP      3328
#define XB_TOPGEN   3392
#define XCD_BAR_WORDS 3456
#define XB_SPIN_CAP (1u << 18)

__device__ __forceinline__ unsigned xb_ld(unsigned* p)              { return __hip_atomic_load(p, __ATOMIC_RELAXED, __HIP_MEMORY_SCOPE_AGENT); }
__device__ __forceinline__ unsigned xb_add(unsigned* p, unsigned v) { return __hip_atomic_fetch_add(p, v, __ATOMIC_RELAXED, __HIP_MEMORY_SCOPE_AGENT); }
__device__ __forceinline__ unsigned xb_xcc_id() { return (unsigned)__builtin_amdgcn_s_getreg((3 << 11) | 20) & 0xFu; }
#define XB_SPIN(cond, bar) do { unsigned _sp = 0; while (cond) { __builtin_amdgcn_s_sleep(1); \
    if ((++_sp & 255u) == 0u) { if (xb_ld(&(bar)[XB_TMO])) break; if (_sp > XB_SPIN_CAP) { atomicAdd(&(bar)[XB_TMO], 1u); break; } } } } while (0)

struct XcdBarrier {
    unsigned* bar; unsigned x;
    volatile LAS unsigned* st;
};

__device__ __forceinline__ XcdBarrier xcd_barrier_post(unsigned* bar, volatile LAS unsigned* st) {
    XcdBarrier b; b.bar = bar; b.x = xb_xcc_id(); b.st = st;
    if (threadIdx.x == 0) (void)xb_add(&bar[XB_XCNT(b.x)], 1u);
    return b;
}
__device__ __forceinline__ void xcd_barrier_complete(unsigned* bar, unsigned x, unsigned& nloc, unsigned& nx) {
    const unsigned G = gridDim.x * gridDim.y * gridDim.z;
    unsigned sum, cnt, mine, sp = 0u;
    for (;;) {
        sum = 0u; cnt = 0u; mine = 0u;
#pragma unroll
        for (unsigned j = 0; j < 16; ++j) { const unsigned c = xb_ld(&bar[XB_XCNT(j)]); sum += c; cnt += (c > 0u) ? 1u : 0u; mine = (j == x) ? c : mine; }
        if (sum == G) break;
        __builtin_amdgcn_s_sleep(1);
        if ((++sp & 255u) == 0u) { if (xb_ld(&bar[XB_TMO])) break; if (sp > XB_SPIN_CAP) { atomicAdd(&bar[XB_TMO], 1u); break; } }
    }
    nloc = mine > 0u ? mine : 1u; nx = cnt > 0u ? cnt : 1u;
}

__device__ __forceinline__ void xcd_barrier(const XcdBarrier& b) {
    asm volatile("s_waitcnt vmcnt(0)" ::: "memory");
    __syncthreads();
    if (threadIdx.x == 0) {
        unsigned* bar = b.bar;
        __builtin_amdgcn_s_waitcnt(0);
        unsigned nloc = b.st[0], nx = b.st[1];
        if (nloc == 0u) { xcd_barrier_complete(bar, b.x, nloc, nx); b.st[0] = nloc; b.st[1] = nx; }
        const unsigned old = xb_add(&bar[XB_XSUB(b.x)], 1u);
        const unsigned gen = old / nloc;
        if (old + 1u == (gen + 1u) * nloc) {
            __builtin_amdgcn_fence(__ATOMIC_RELEASE, "agent");
            asm volatile("s_waitcnt vmcnt(0)" ::: "memory");
            const unsigned og = xb_add(&bar[XB_TOP], 1u);
            const unsigned tg = og / nx;
            if (og + 1u == (tg + 1u) * nx) xb_add(&bar[XB_TOPGEN], 1u);
            else XB_SPIN(xb_ld(&bar[XB_TOPGEN]) == tg, bar);
            __builtin_amdgcn_fence(__ATOMIC_ACQUIRE, "agent");
            xb_add(&bar[XB_XGEN(b.x)], 1u);
            asm volatile("s_waitcnt vmcnt(0)" ::: "memory");
        } else {
            XB_SPIN(xb_ld(&bar[XB_XGEN(b.x)]) == gen, bar);
            __builtin_amdgcn_fence(__ATOMIC_ACQUIRE, "agent");
            asm volatile("s_waitcnt vmcnt(0)" ::: "memory");
        }
    }
    __syncthreads();
}

__global__ void __launch_bounds__(512, 2) fwd_megakernel(Args a) {
    extern __shared__ __attribute__((aligned(16))) unsigned char lds_raw[];
    LAS unsigned char* lds = (LAS unsigned char*)lds_raw;
    cg::grid_group grid = cg::this_grid();
    const int G = gridDim.x;
    unsigned char* ws = a.ws;
    bf16* XB = (bf16*)(ws + WS_XB); bf16* HB = (bf16*)(ws + WS_HB); bf16* BR = (bf16*)(ws + WS_BR);

    volatile LAS unsigned* MISC = (volatile LAS unsigned*)(lds + MISC_OFF);
    if (threadIdx.x < 2) MISC[threadIdx.x] = 0u;
    unsigned* barw = (unsigned*)(ws + WS_BAR);
    if (blockIdx.x == 0) for (int i = threadIdx.x; i < XCD_BAR_WORDS; i += 512) __hip_atomic_store(barw + i, 0u, __ATOMIC_RELAXED, __HIP_MEMORY_SCOPE_AGENT);
    prologue(a, lds);
    grid.sync();
    const XcdBarrier xbar = xcd_barrier_post(barw, MISC);

    for (int layer = 0; layer < 4; ++layer) {
        {
            const int N = layer == 0 ? 2304 : layer == 1 ? 1536 : layer == 2 ? 2304 : 3328;
            const size_t woff = layer == 0 ? WS_WIN0 : layer == 1 ? WS_WIN1 : layer == 2 ? WS_WIN2 : WS_WIN3;
            EpiAct E;
            E.O = HB;
            if (layer == 0)      { E.ldc = 2304; E.t1 = 8; E.t2 = 9;  E.m0 = 1; E.m1 = 0; E.m2 = 0; E.c0 = 0; E.c1 = 2048; E.c2 = 0; }
            else if (layer == 1) { E.ldc = 1536; E.t1 = 6; E.t2 = 6;  E.m0 = 0; E.m1 = 0; E.m2 = 0; E.c0 = 0; E.c1 = 0;    E.c2 = 0; }
            else if (layer == 2) { E.ldc = 1280; E.t1 = 8; E.t2 = 9;  E.m0 = 2; E.m1 = 0; E.m2 = 0; E.c0 = 0; E.c1 = 1024; E.c2 = 0; }
            else                 { E.ldc = 2304; E.t1 = 4; E.t2 = 12; E.m0 = 0; E.m1 = 3; E.m2 = 0; E.c0 = 0; E.c1 = 1024; E.c2 = 2048; }
            pg8::Gemm g{XB, (const bf16*)(ws + woff), M, N, 1024}; pg8::StaticOrder S; S.init(M, N, G, (int)blockIdx.x);
            pg8::gemm_phase<EpiAct, pg8::StaticOrder, true, true>(lds, g, S, E);
            if (layer == 0) {
                for (int l = 0; l < 4; ++l) {
                    EpiAct E2; E2.O = (bf16*)(ws + WS_KVM) + (size_t)l * 512 * 512; E2.ldc = 512; E2.t1 = 2; E2.t2 = 2; E2.m0 = 0; E2.m1 = 0; E2.m2 = 0; E2.c0 = 0; E2.c1 = 0; E2.c2 = 0;
                    pg8::Gemm g2{(const bf16*)(ws + WS_MEMB), (const bf16*)(ws + WS_WKV) + (size_t)l * 512 * 1024, 512, 512, 1024};
                    pg8::StaticOrder S2; S2.init(512, 512, G, (int)((blockIdx.x + G - (128 + 4 * l) % G) % G));
                    pg8::gemm_phase<EpiAct, pg8::StaticOrder, true, true>(lds, g2, S2, E2);
                }
            }
        }
        xcd_barrier(xbar);
        if (layer == 0)      sgu_phase(a, lds);
        else if (layer == 1) swa_phase(a, lds);
        else if (layer == 2) conv31_phase(a, lds);
        else                 conv3_phase(a);
        xattn_phase(a, layer, layer == 1 ? 1536 : layer == 2 ? 1280 : 2304, layer == 1 ? 1280 : layer == 2 ? 1024 : 2048, lds);
        xcd_barrier(xbar);
        {
            EpiRes E{layer == 0 ? a.in[0] : a.out, a.out, ALPHA};
            pg8::Gemm g{BR, (const bf16*)(ws + WS_WO) + (size_t)layer * 1280 * 1024, M, 1024, 1280}; pg8::StaticOrder S; S.init(M, 1024, G, (int)blockIdx.x);
            pg8::gemm_phase<EpiRes, pg8::StaticOrder, true, true>(lds, g, S, E);
        }
        xcd_barrier(xbar);
        ln_phase(a.out, XB, a.in[19] + layer * D, a.in[20] + layer * D);
        xcd_barrier(xbar);
        {
            EpiAct E; E.O = HB; E.ldc = DFF; E.t1 = 22; E.t2 = 22; E.m0 = 4; E.m1 = 0; E.m2 = 0; E.c0 = 0; E.c1 = 0; E.c2 = 0;
            pg8::Gemm g{XB, (const bf16*)(ws + WS_WF1) + (size_t)layer * 5632 * 1024, M, 5632, 1024}; pg8::StaticOrder S; S.init(M, 5632, G, (int)blockIdx.x);
            pg8::gemm_phase<EpiAct, pg8::StaticOrder, true, true>(lds, g, S, E);
        }
        xcd_barrier(xbar);
        {
            EpiRes E{a.out, a.out, ALPHA};
            pg8::Gemm g{HB, (const bf16*)(ws + WS_WF2) + (size_t)layer * 2816 * 1024, M, 1024, 2816}; pg8::StaticOrder S; S.init(M, 1024, G, (int)blockIdx.x);
            pg8::gemm_phase<EpiRes, pg8::StaticOrder, true, true>(lds, g, S, E);
        }
        xcd_barrier(xbar);
        ln_phase(a.out, XB, a.in[23] + layer * D, a.in[24] + layer * D);
        if (layer < 3) xcd_barrier(xbar);
    }
}

extern "C" void kernel_launch(void* const* d_in, const int* in_sizes, int n_in, void* d_out, int out_size, void* d_ws, size_t ws_size, hipStream_t stream) {
    static int grid = 0;
    if (grid == 0) {
        if (n_in != 25 || out_size != M * D || ws_size < WS_END) { fprintf(stderr, "kernel_launch: unexpected problem (n_in %d, out %d, ws %zu)\n", n_in, out_size, ws_size); grid = -1; return; }
        int dev = 0, cus = 0, per_cu = 0;
        (void)hipGetDevice(&dev);
        (void)hipDeviceGetAttribute(&cus, hipDeviceAttributeMultiprocessorCount, dev);
        (void)hipFuncSetAttribute((const void*)fwd_megakernel, hipFuncAttributeMaxDynamicSharedMemorySize, LDS_BYTES);
        (void)hipOccupancyMaxActiveBlocksPerMultiprocessor(&per_cu, (const void*)fwd_megakernel, 512, LDS_BYTES);
        if (per_cu < 1) per_cu = 1;
        grid = cus * per_cu;
        (void)hipGetLastError();
    }
    if (grid < 0) return;
    Args a{};
    for (int i = 0; i < 25; ++i) a.in[i] = (const float*)d_in[i];
    a.out = (float*)d_out; a.ws = (unsigned char*)d_ws;
    void* args[] = {&a};
    hipError_t e = hipLaunchCooperativeKernel((const void*)fwd_megakernel, dim3(grid), dim3(512), args, LDS_BYTES, stream);
    if (e != hipSuccess) fprintf(stderr, "cooperative launch failed: %s (grid %d)\n", hipGetErrorString(e), grid);
}
```
